# Optimizing an MI355X kernel written in HIP

```python
import jax, jax.numpy as jnp
from jax import lax
import numpy as np

D_MODEL = 2048
BATCH = 4
SEQ = 2048
DEPTH = 1
DEC_BATCH = 16
DEC_SEQ = 2048
PAST_LEN = 128

HEAD_DIM = 128
N_Q_HEADS = D_MODEL // HEAD_DIM
N_KV_HEADS = N_Q_HEADS // 4
Q_PER_KV = N_Q_HEADS // N_KV_HEADS
ATTN_WIDTH = N_Q_HEADS * HEAD_DIM
KV_WIDTH = N_KV_HEADS * HEAD_DIM
N_FOURIER_GROUPS = 4
FOURIER_WIDTH = D_MODEL // 2
FOURIER_GROUP_DIM = FOURIER_WIDTH // N_FOURIER_GROUPS
IN_WIDTH = ATTN_WIDTH + 2 * KV_WIDTH + FOURIER_WIDTH
WINDOW = 128
BLOCK = 128
D_FF = -(-8 * D_MODEL // (3 * 256)) * 256
N_MOD = 6
RMS_EPS = 1e-6

kernel_name = "hybrid_gated_fnet_swa_encoder"


def rmsnorm(x, g):
    xf = x.astype(jnp.float32)
    y = xf * lax.rsqrt(jnp.mean(xf * xf, axis=-1, keepdims=True) + RMS_EPS)
    return (y * g.astype(jnp.float32)).astype(x.dtype)


def alibi_slopes():
    h = jnp.arange(1, N_Q_HEADS + 1, dtype=jnp.float32)
    return jnp.exp2(-8.0 * h / N_Q_HEADS).reshape(N_KV_HEADS, Q_PER_KV)


def banded_window_attention(q, k, v, sink):
    B, S = q.shape[0], q.shape[1]
    nb = S // BLOCK
    pad = ((0, 0), (BLOCK, BLOCK), (0, 0), (0, 0))
    kp = jnp.pad(k, pad)
    vp = jnp.pad(v, pad)
    qb = jnp.moveaxis(q.reshape(B, nb, BLOCK, N_KV_HEADS, Q_PER_KV, HEAD_DIM), 1, 0)
    a = jnp.arange(BLOCK)[:, None]
    j = jnp.arange(3 * BLOCK)[None, :]
    rel = j - BLOCK - a
    dist = jnp.abs(rel).astype(jnp.float32)
    in_window = jnp.abs(rel) <= WINDOW
    slopes = alibi_slopes()
    bias = -slopes[:, :, None, None] * dist[None, None]
    sink_l = sink.astype(jnp.float32).reshape(N_KV_HEADS, Q_PER_KV)
    scale = HEAD_DIM ** -0.5

    def one_block(args):
        i, qi = args
        start = i * BLOCK
        ki = lax.dynamic_slice_in_dim(kp, start, 3 * BLOCK, axis=1)
        vi = lax.dynamic_slice_in_dim(vp, start, 3 * BLOCK, axis=1)
        key_pos = start - BLOCK + jnp.arange(3 * BLOCK)
        valid = in_window & ((key_pos >= 0) & (key_pos < S))[None, :]
        s = jnp.einsum('bqkgd,bskd->bkgqs', qi, ki,
                       preferred_element_type=jnp.float32) * scale + bias
        s = jnp.where(valid, s, -jnp.inf)
        sink_col = jnp.broadcast_to(sink_l[None, :, :, None, None], s.shape[:-1] + (1,))
        p = jax.nn.softmax(jnp.concatenate([s, sink_col], axis=-1), axis=-1)[..., :-1]
        return jnp.einsum('bkgqs,bskd->bqkgd', p.astype(vi.dtype), vi)

    out = lax.map(one_block, (jnp.arange(nb), qb))
    return jnp.moveaxis(out, 0, 1).reshape(B, S, ATTN_WIDTH)


def fourier_mix(u):
    B, S = u.shape[0], u.shape[1]
    ug = u.astype(jnp.float32).reshape(B, S, N_FOURIER_GROUPS, FOURIER_GROUP_DIM)
    z = jnp.fft.fft2(ug, axes=(1, 3), norm="ortho")
    return jnp.real(z).reshape(B, S, FOURIER_WIDTH).astype(u.dtype)


def encoder_layer(x, c, w_mod, b_mod, g_mix, w_in, attn_sink, w_attn_branch,
                  w_fourier_branch, w_gate, b_gate, w_out, g_ffn, w_up, w_down):
    B, S = x.shape[0], x.shape[1]
    mod = (jax.nn.silu(c) @ w_mod + b_mod)[:, None, :]
    shift1, scale1, gate1, shift2, scale2, gate2 = jnp.split(mod, N_MOD, axis=-1)

    h = rmsnorm(x, g_mix) * (1.0 + scale1) + shift1
    proj = h @ w_in
    q, k, v, u = jnp.split(proj, [ATTN_WIDTH, ATTN_WIDTH + KV_WIDTH,
                                  ATTN_WIDTH + 2 * KV_WIDTH], axis=-1)
    q = q.reshape(B, S, N_KV_HEADS, Q_PER_KV, HEAD_DIM)
    k = k.reshape(B, S, N_KV_HEADS, HEAD_DIM)
    v = v.reshape(B, S, N_KV_HEADS, HEAD_DIM)
    attn = banded_window_attention(q, k, v, attn_sink) @ w_attn_branch
    four = fourier_mix(u) @ w_fourier_branch
    g_attn, g_four = jnp.split(jax.nn.sigmoid(h @ w_gate + b_gate), 2, axis=-1)
    merged = g_attn * attn + g_four * four
    x = x + gate1 * (merged @ w_out)

    h2 = rmsnorm(x, g_ffn) * (1.0 + scale2) + shift2
    gt, up = jnp.split(h2 @ w_up, 2, axis=-1)
    x = x + gate2 * ((jax.nn.silu(gt) * up) @ w_down)
    return x


def trunk(x, c, w_mod, b_mod, g_mix, w_in, attn_sink, w_attn_branch, w_fourier_branch,
          w_gate, b_gate, w_out, g_ffn, w_up, w_down, g_final):
    for l in range(DEPTH):
        x = encoder_layer(x, c, w_mod[l], b_mod[l], g_mix[l], w_in[l], attn_sink[l],
                          w_attn_branch[l], w_fourier_branch[l], w_gate[l], b_gate[l],
                          w_out[l], g_ffn[l], w_up[l], w_down[l])
    return rmsnorm(x, g_final)


def setup_inputs(seed: int = 0) -> dict:
    key = jax.random.key(seed)
    ks = jax.random.split(key, 20)
    f32 = jnp.float32

    def dense(k, fan_in, fan_out, gain=1.0):
        return jax.random.normal(k, (DEPTH, fan_in, fan_out), f32) * (gain * fan_in ** -0.5)

    def gain_vec(k, n):
        return 1.0 + 0.02 * jax.random.normal(k, (DEPTH, n), f32)

    return {
        "x_prompt": jax.random.normal(ks[0], (BATCH, SEQ, D_MODEL), f32),
        "x_sample": jax.random.normal(ks[1], (DEC_BATCH, DEC_SEQ, D_MODEL), f32),
        "c_prompt": jax.random.normal(ks[2], (BATCH, D_MODEL), f32),
        "c_sample": jax.random.normal(ks[3], (DEC_BATCH, D_MODEL), f32),
        "w_mod": dense(ks[4], D_MODEL, N_MOD * D_MODEL, 0.5),
        "b_mod": 0.02 * jax.random.normal(ks[5], (DEPTH, N_MOD * D_MODEL), f32),
        "g_mix": gain_vec(ks[6], D_MODEL),
        "w_in": dense(ks[7], D_MODEL, IN_WIDTH),
        "attn_sink": 0.5 * jax.random.normal(ks[8], (DEPTH, N_Q_HEADS), f32),
        "w_attn_branch": dense(ks[9], ATTN_WIDTH, D_MODEL),
        "w_fourier_branch": dense(ks[10], FOURIER_WIDTH, D_MODEL),
        "w_gate": dense(ks[11], D_MODEL, 2 * D_MODEL),
        "b_gate": 0.02 * jax.random.normal(ks[12], (DEPTH, 2 * D_MODEL), f32),
        "w_out": dense(ks[13], D_MODEL, D_MODEL),
        "g_ffn": gain_vec(ks[14], D_MODEL),
        "w_up": dense(ks[15], D_MODEL, 2 * D_FF),
        "w_down": dense(ks[16], D_FF, D_MODEL),
        "g_final": 1.0 + 0.02 * jax.random.normal(ks[17], (D_MODEL,), f32),
    }


def reference(x_prompt, x_sample, c_prompt, c_sample, w_mod, b_mod, g_mix, w_in,
              attn_sink, w_attn_branch, w_fourier_branch, w_gate, b_gate, w_out,
              g_ffn, w_up, w_down, g_final):
    y_prompt = trunk(x_prompt, c_prompt, w_mod, b_mod, g_mix, w_in, attn_sink,
                     w_attn_branch, w_fourier_branch, w_gate, b_gate, w_out,
                     g_ffn, w_up, w_down, g_final)
    y_sample = trunk(x_sample, c_sample, w_mod, b_mod, g_mix, w_in, attn_sink,
                     w_attn_branch, w_fourier_branch, w_gate, b_gate, w_out,
                     g_ffn, w_up, w_down, g_final)
    return (y_prompt, y_sample)
```

```cpp
#include <hip/hip_runtime.h>
#include <hip/hip_cooperative_groups.h>
#include <cstdio>
#include <cstdint>
namespace cg = cooperative_groups;

#define LAS __attribute__((address_space(3)))
typedef unsigned short bf16_t;
typedef short bf16x8 __attribute__((ext_vector_type(8)));
typedef short s16x4 __attribute__((ext_vector_type(4)));
typedef float f32x4 __attribute__((ext_vector_type(4)));
typedef float f32x2 __attribute__((ext_vector_type(2)));
typedef float f32x16 __attribute__((ext_vector_type(16)));
typedef unsigned u32x4 __attribute__((ext_vector_type(4)));
typedef unsigned u32x2 __attribute__((ext_vector_type(2)));

constexpr int DM = 2048, SEQ = 2048, NBATCH = 20, MTOK = NBATCH * SEQ, NPR = 4 * SEQ;
constexpr int DFF = 5632, NMOD = 6 * DM;
constexpr float RMS_EPS = 1e-6f;
constexpr float LOG2E = 1.4426950408889634f;
constexpr size_t MiB = 1u << 20;
constexpr size_t WS_CTL = 0, WS_MOD = 4096;
constexpr size_t WS_WIN = 1 * MiB, WS_WU = 29 * MiB, WS_WA = 37 * MiB, WS_WF = 45 * MiB, WS_WO = 49 * MiB, WS_WUP = 57 * MiB, WS_WD = 101 * MiB, WS_FT = 123 * MiB;
constexpr size_t WS_H = 140 * MiB, WS_QKV = 300 * MiB, WS_UT = 540 * MiB, WS_AO = 700 * MiB, WS_RE = 860 * MiB, WS_END = 940 * MiB;
constexpr size_t WS_TMP = WS_H, WS_MERGED = WS_QKV, WS_ACT = WS_QKV;
constexpr int LDS_BYTES = 147456;
constexpr int NWAVES = 8;

__device__ __forceinline__ unsigned cvt_pk_bf16(float lo, float hi) { unsigned r; asm volatile("v_cvt_pk_bf16_f32 %0, %1, %2" : "=v"(r) : "v"(lo), "v"(hi)); return r; }
__device__ __forceinline__ float bf_lo(unsigned w) { return __uint_as_float(w << 16); }
__device__ __forceinline__ float bf_hi(unsigned w) { return __uint_as_float(w & 0xffff0000u); }
__device__ __forceinline__ float sigmoidf_(float v) { return __builtin_amdgcn_rcpf(1.0f + __builtin_amdgcn_exp2f(-v * LOG2E)); }
__device__ __forceinline__ float wave_sum(float v) {
#pragma unroll
    for (int o = 1; o < 64; o <<= 1) v += __shfl_xor(v, o);
    return v;
}

namespace pg8 {
constexpr int BM = 256, BK = 64, HALF = 128, HTB = HALF * BK * 2, STAGE_BYTES = 8 * HTB, NXCD = 8, WGM = 8;
__host__ __device__ __forceinline__ int lds_byte(int r, int c) { const int st = (r >> 4) * 2 + (c >> 5), rr = r & 15, cc = c & 31, ob = rr * 64 + cc * 2; return st * 1024 + (ob ^ (((ob >> 9) & 1) << 5)); }
__host__ __device__ __forceinline__ void stage_rc(int b, int& R, int& C) { const int st = b / 1024, sb = b % 1024, swz = sb ^ (((sb >> 9) & 1) << 5); R = (st >> 1) * 16 + swz / 64; C = (st & 1) * 32 + (swz % 64) / 2; }
__host__ __device__ __forceinline__ int perm32(int rho) { const int n = rho >> 4, i = rho & 15; return 8 * (i >> 2) + 4 * n + (i & 3); }

struct Unit { int pm, pn, ta, tb; };
struct Order {
    int nM, nN, nwg, G, c, dft;
    __device__ void init(int nM_, int nN_, int G_, int c_, int dft_) { nM = nM_; nN = nN_; nwg = nM * nN; G = G_; c = c_; dft = dft_; }
    __device__ bool next(int i, Unit& u) const {
        const long L = (long)i * G + c; if (L >= nwg) return false;
        int wgid = (int)L; { const int q = nwg / NXCD, r = nwg % NXCD, xcd = wgid % NXCD, off = wgid / NXCD; wgid = (xcd < r ? xcd * (q + 1) : r * (q + 1) + (xcd - r) * q) + off; }
        const int nig = WGM * nN, gid = wgid / nig, fm = gid * WGM, gsz = (nM - fm) < WGM ? (nM - fm) : WGM;
        u.pm = fm + ((wgid % nig) % gsz); u.pn = (wgid % nig) / gsz;
        u.ta = dft ? (u.pm & 7) : u.pm; u.tb = dft ? ((u.pm >> 3) * 4 + u.pn) : u.pn;
        return true;
    }
};

template <class Epi, bool ALIGN_EPI, bool SP2>
__device__ __forceinline__ void gemm_phase(LAS unsigned char* lds, const bf16_t* gA, const bf16_t* gBt, const int K, const Order& S, const Epi& E) {
    const int tid = threadIdx.x, wid = __builtin_amdgcn_readfirstlane(tid >> 6), lane = tid & 63, wr = wid >> 2, wc = wid & 3, fr = lane & 15, fq = lane >> 4;
    const int nt = K / BK;
    unsigned voffA[2], voffB[2];
#pragma unroll
    for (int i = 0; i < 2; ++i) { int R, C; stage_rc(tid * 16 + i * 8192, R, C); const int Rb = Epi::PERM ? ((R & ~31) + perm32(R & 31)) : R;
        voffA[i] = (unsigned)(R * K + C) * 2u; voffB[i] = (unsigned)(Rb * K + C) * 2u; }
    const size_t kstep = (size_t)(BK * 2);
    const size_t hstep = (size_t)HALF * K * 2;
    const size_t tstep = 2 * hstep;
    const unsigned ldsw = (unsigned)wid * 1024u;
    const int aoff = lds_byte(wr * 64 + fr, fq * 8), boff = lds_byte(wc * 32 + fr, fq * 8);
#define PG8_SA(b, h) (((b) * 2 + (h)) * HTB)
#define PG8_SB(b, h) ((4 + (b) * 2 + (h)) * HTB)
#define PG8_STAGE(bufoff, gbase, voff) do { _Pragma("unroll") for (int _i = 0; _i < 2; ++_i) \
        __builtin_amdgcn_global_load_lds((const unsigned*)((const char*)(gbase) + (voff)[_i]), (LAS unsigned*)(lds + (bufoff) + ldsw + _i * 8192), 16, 0, 0); } while (0)
#define PG8_LDA(dst, b, h) do { _Pragma("unroll") for (int m = 0; m < 4; ++m) _Pragma("unroll") for (int k = 0; k < 2; ++k) dst[m][k] = *(const LAS bf16x8*)(lds + PG8_SA(b, h) + aoff + m * 2048 + k * 1024); } while (0)
#define PG8_LDB(dst, b, h) do { _Pragma("unroll") for (int n = 0; n < 2; ++n) _Pragma("unroll") for (int k = 0; k < 2; ++k) dst[n][k] = *(const LAS bf16x8*)(lds + PG8_SB(b, h) + boff + n * 2048 + k * 1024); } while (0)
#define PG8_MMA(ai, bj, At, Bt) do { __builtin_amdgcn_s_setprio(1); _Pragma("unroll") for (int m = 0; m < 4; ++m) _Pragma("unroll") for (int n = 0; n < 2; ++n) _Pragma("unroll") for (int k = 0; k < 2; ++k) \
        acc[ai][bj][m][n] = __builtin_amdgcn_mfma_f32_16x16x32_bf16(Bt[n][k], At[m][k], acc[ai][bj][m][n], 0, 0, 0); __builtin_amdgcn_s_setprio(0); } while (0)
#define PG8_WAIT_V(n) asm volatile("s_waitcnt vmcnt(" #n ")" ::: "memory")
#define PG8_WAIT_L(n) asm volatile("s_waitcnt lgkmcnt(" #n ")" ::: "memory")
#define PG8_BAR __builtin_amdgcn_s_barrier()
#define PG8_SCHED __builtin_amdgcn_sched_barrier(0)
    Unit cur, nxt; int ui = 0;
    if (!S.next(0, cur)) return;
    f32x4 acc[2][2][4][2];
#pragma unroll
    for (int a = 0; a < 2; ++a)
#pragma unroll
        for (int b = 0; b < 2; ++b)
#pragma unroll
            for (int m = 0; m < 4; ++m)
#pragma unroll
                for (int n = 0; n < 2; ++n) acc[a][b][m][n] = (f32x4){0.f, 0.f, 0.f, 0.f};
    bf16x8 At[4][2], B0[2][2], B1[2][2];
    const char* cA = (const char*)gA + (size_t)cur.ta * tstep; const char* cB = (const char*)gBt + (size_t)cur.tb * tstep;
    if constexpr (SP2) {
        PG8_STAGE(PG8_SB(0, 0), cB, voffB); PG8_STAGE(PG8_SB(0, 1), cB + hstep, voffB); PG8_STAGE(PG8_SA(0, 0), cA, voffA); PG8_STAGE(PG8_SA(0, 1), cA + hstep, voffA);
        if (wr == 1) PG8_BAR;
        PG8_WAIT_V(2); PG8_BAR;
        PG8_STAGE(PG8_SB(1, 0), cB + kstep, voffB); PG8_STAGE(PG8_SA(1, 0), cA + kstep, voffA); PG8_STAGE(PG8_SB(1, 1), cB + hstep + kstep, voffB);
        PG8_WAIT_V(6); PG8_BAR;
    } else {
        PG8_STAGE(PG8_SB(0, 0), cB, voffB); PG8_STAGE(PG8_SA(0, 0), cA, voffA); PG8_STAGE(PG8_SB(0, 1), cB + hstep, voffB); PG8_STAGE(PG8_SA(0, 1), cA + hstep, voffA);
        if (wr == 1) PG8_BAR;
        PG8_WAIT_V(4); PG8_BAR;
        PG8_STAGE(PG8_SB(1, 0), cB + kstep, voffB); PG8_STAGE(PG8_SA(1, 0), cA + kstep, voffA); PG8_STAGE(PG8_SB(1, 1), cB + hstep + kstep, voffB);
        PG8_WAIT_V(6); PG8_BAR;
    }
    for (;;) {
        const bool has_next = S.next(ui + 1, nxt);
        const char* nA = has_next ? (const char*)gA + (size_t)nxt.ta * tstep : cA; const char* nB = has_next ? (const char*)gBt + (size_t)nxt.tb * tstep : cB;
        for (int t = 0; t < nt; t += 2) {
            const bool last = (t == nt - 2);
            const char* a1 = cA + (size_t)(t + 1) * kstep;
            const char* a2 = last ? nA : cA + (size_t)(t + 2) * kstep; const char* b2 = last ? nB : cB + (size_t)(t + 2) * kstep;
            const char* a3 = a2 + kstep; const char* b3 = b2 + kstep;
            if constexpr (SP2) {
            PG8_LDB(B0, 0, 0); PG8_LDB(B1, 0, 1); PG8_SCHED; PG8_LDA(At, 0, 0); PG8_STAGE(PG8_SA(1, 1), a1 + hstep, voffA);
            PG8_WAIT_V(8); PG8_WAIT_L(0); PG8_BAR; PG8_MMA(0, 0, At, B0); PG8_MMA(0, 1, At, B1); PG8_BAR; PG8_SCHED;
            PG8_LDA(At, 0, 1); PG8_STAGE(PG8_SB(0, 0), b2, voffB); PG8_STAGE(PG8_SB(0, 1), b2 + hstep, voffB); PG8_STAGE(PG8_SA(0, 0), a2, voffA);
            PG8_WAIT_V(8); PG8_WAIT_L(0); PG8_BAR; PG8_MMA(1, 0, At, B0); PG8_MMA(1, 1, At, B1); PG8_BAR; PG8_SCHED;
            PG8_LDB(B0, 1, 0); PG8_LDB(B1, 1, 1); PG8_SCHED; PG8_LDA(At, 1, 0); PG8_STAGE(PG8_SA(0, 1), a2 + hstep, voffA);
            PG8_WAIT_V(8); PG8_WAIT_L(0); PG8_BAR; PG8_MMA(0, 0, At, B0); PG8_MMA(0, 1, At, B1); PG8_BAR; PG8_SCHED;
            PG8_LDA(At, 1, 1); PG8_STAGE(PG8_SB(1, 0), b3, voffB); PG8_STAGE(PG8_SB(1, 1), b3 + hstep, voffB); PG8_STAGE(PG8_SA(1, 0), a3, voffA);
            PG8_WAIT_V(8); PG8_WAIT_L(0); PG8_BAR; PG8_MMA(1, 0, At, B0); PG8_MMA(1, 1, At, B1); PG8_BAR; PG8_SCHED;
            } else {
            PG8_LDB(B0, 0, 0); PG8_SCHED; PG8_LDA(At, 0, 0); PG8_STAGE(PG8_SA(1, 1), a1 + hstep, voffA);
            PG8_WAIT_L(8); PG8_BAR; PG8_WAIT_L(0); PG8_MMA(0, 0, At, B0); PG8_BAR; PG8_SCHED;
            PG8_LDB(B1, 0, 1); PG8_STAGE(PG8_SB(0, 0), b2, voffB);
            PG8_BAR; PG8_WAIT_L(0); PG8_MMA(0, 1, At, B1); PG8_BAR;
            PG8_LDA(At, 0, 1); PG8_STAGE(PG8_SA(0, 0), a2, voffA);
            PG8_BAR; PG8_WAIT_L(0); PG8_MMA(1, 0, At, B0); PG8_BAR; PG8_SCHED;
            PG8_STAGE(PG8_SB(0, 1), b2 + hstep, voffB);
            PG8_WAIT_V(6); PG8_BAR; PG8_MMA(1, 1, At, B1); PG8_BAR;
            PG8_LDB(B0, 1, 0); PG8_SCHED; PG8_LDA(At, 1, 0); PG8_STAGE(PG8_SA(0, 1), a2 + hstep, voffA);
            PG8_WAIT_L(8); PG8_BAR; PG8_WAIT_L(0); PG8_MMA(0, 0, At, B0); PG8_BAR; PG8_SCHED;
            PG8_LDB(B1, 1, 1); PG8_STAGE(PG8_SB(1, 0), b3, voffB);
            PG8_BAR; PG8_WAIT_L(0); PG8_MMA(0, 1, At, B1); PG8_BAR;
            PG8_LDA(At, 1, 1); PG8_STAGE(PG8_SA(1, 0), a3, voffA);
            PG8_BAR; PG8_WAIT_L(0); PG8_MMA(1, 0, At, B0); PG8_BAR; PG8_SCHED;
            PG8_STAGE(PG8_SB(1, 1), b3 + hstep, voffB);
            PG8_WAIT_V(6); PG8_BAR; PG8_MMA(1, 1, At, B1); PG8_BAR;
            }
        }
        if constexpr (ALIGN_EPI) { if (wr == 0) PG8_BAR; }
        E(acc, cur, wr, wc, fr, fq);
        if (!has_next) break;
#pragma unroll
        for (int a = 0; a < 2; ++a)
#pragma unroll
            for (int b = 0; b < 2; ++b)
#pragma unroll
                for (int m = 0; m < 4; ++m)
#pragma unroll
                    for (int n = 0; n < 2; ++n) acc[a][b][m][n] = (f32x4){0.f, 0.f, 0.f, 0.f};
        cur = nxt; cA = nA; cB = nB; ++ui;
        if constexpr (ALIGN_EPI) { if (wr == 1) PG8_BAR; }
    }
    PG8_WAIT_V(0);
    if constexpr (!ALIGN_EPI) { if (wr == 0) PG8_BAR; }
    PG8_BAR;
#undef PG8_SA
#undef PG8_SB
#undef PG8_STAGE
#undef PG8_LDA
#undef PG8_LDB
#undef PG8_MMA
#undef PG8_WAIT_V
#undef PG8_WAIT_L
#undef PG8_BAR
#undef PG8_SCHED
}

typedef const f32x4 (&AccRef)[2][2][4][2];
__device__ __forceinline__ u32x4 pack8(f32x4 v0, f32x4 v1) { u32x4 w; w.x = cvt_pk_bf16(v0[0], v0[1]); w.y = cvt_pk_bf16(v0[2], v0[3]); w.z = cvt_pk_bf16(v1[0], v1[1]); w.w = cvt_pk_bf16(v1[2], v1[3]); return w; }

struct EpiQKVG {
    static constexpr bool PERM = true;
    bf16_t* qkv; bf16_t* gate; const float* bgate;
    __device__ __forceinline__ void operator()(AccRef acc, const Unit& u, int wr, int wc, int fr, int fq) const {
        const int row0 = u.pm * BM + wr * 64 + fr; const bool isg = u.pn >= 12;
        const int col0 = (isg ? (u.pn - 12) : u.pn) * BM + wc * 32 + 8 * fq; bf16_t* base = isg ? gate : qkv; const int ldc = isg ? 4096 : 3072;
        f32x4 bv[2][2];
#pragma unroll
        for (int bj = 0; bj < 2; ++bj)
#pragma unroll
            for (int n = 0; n < 2; ++n) bv[bj][n] = isg ? *(const f32x4*)(bgate + col0 + bj * HALF + 4 * n) : (f32x4){0.f, 0.f, 0.f, 0.f};
#pragma unroll
        for (int ai = 0; ai < 2; ++ai)
#pragma unroll
            for (int m = 0; m < 4; ++m) { bf16_t* rowp = base + (size_t)(row0 + ai * HALF + m * 16) * ldc + col0;
#pragma unroll
                for (int bj = 0; bj < 2; ++bj) { f32x4 v0 = acc[ai][bj][m][0] + bv[bj][0], v1 = acc[ai][bj][m][1] + bv[bj][1];
                    if (isg) {
#pragma unroll
                        for (int j = 0; j < 4; ++j) { v0[j] = sigmoidf_(v0[j]); v1[j] = sigmoidf_(v1[j]); } }
                    *(u32x4*)(rowp + bj * HALF) = pack8(v0, v1); } }
    }
};
struct EpiBf16 {
    static constexpr bool PERM = true;
    bf16_t* out; int ld; int ut;
    __device__ __forceinline__ void operator()(AccRef acc, const Unit& u, int wr, int wc, int fr, int fq) const {
        size_t tb;
        if (ut) { const int part = u.pm >> 2, cbase = (u.pm & 3) * 256, b = u.pn >> 3, sbase = (u.pn & 7) * 256; tb = ((size_t)(b * 1024 + cbase) * 2 + part) * 2048 + sbase; }
        else tb = (size_t)u.pm * BM * ld + (size_t)u.pn * BM;
        bf16_t* p0 = out + tb + (size_t)(wr * 64 + fr) * ld + wc * 32 + 8 * fq;
#pragma unroll
        for (int ai = 0; ai < 2; ++ai)
#pragma unroll
            for (int m = 0; m < 4; ++m) { bf16_t* rowp = p0 + (size_t)(ai * HALF + m * 16) * ld;
#pragma unroll
                for (int bj = 0; bj < 2; ++bj) *(u32x4*)(rowp + bj * HALF) = pack8(acc[ai][bj][m][0], acc[ai][bj][m][1]); }
    }
};
template <int PART> struct EpiMerge {
    static constexpr bool PERM = true;
    const bf16_t* G; const bf16_t* tmp_in; bf16_t* out;
    __device__ __forceinline__ void operator()(AccRef acc, const Unit& u, int wr, int wc, int fr, int fq) const {
        const int row0 = u.pm * BM + wr * 64 + fr, col0 = u.pn * BM + wc * 32 + 8 * fq;
#pragma unroll
        for (int ai = 0; ai < 2; ++ai)
#pragma unroll
            for (int m = 0; m < 4; ++m) { const size_t row = (size_t)(row0 + ai * HALF + m * 16);
#pragma unroll
                for (int bj = 0; bj < 2; ++bj) { const int col = col0 + bj * HALF;
                    const u32x4 g = *(const u32x4*)(G + row * 4096 + PART * 2048 + col);
                    f32x4 v0 = acc[ai][bj][m][0], v1 = acc[ai][bj][m][1];
                    v0[0] *= bf_lo(g.x); v0[1] *= bf_hi(g.x); v0[2] *= bf_lo(g.y); v0[3] *= bf_hi(g.y); v1[0] *= bf_lo(g.z); v1[1] *= bf_hi(g.z); v1[2] *= bf_lo(g.w); v1[3] *= bf_hi(g.w);
                    if (PART == 1) { const u32x4 t = *(const u32x4*)(tmp_in + row * 2048 + col);
                        v0[0] += bf_lo(t.x); v0[1] += bf_hi(t.x); v0[2] += bf_lo(t.y); v0[3] += bf_hi(t.y); v1[0] += bf_lo(t.z); v1[1] += bf_hi(t.z); v1[2] += bf_lo(t.w); v1[3] += bf_hi(t.w); }
                    *(u32x4*)(out + row * 2048 + col) = pack8(v0, v1); } }
    }
};
struct EpiRes {
    static constexpr bool PERM = false;
    const float* base0; const float* base1; int split; const float* gate; float* out;
    __device__ __forceinline__ void operator()(AccRef acc, const Unit& u, int wr, int wc, int fr, int fq) const {
        const int rl0 = wr * 64 + fr, col0 = u.pn * BM + wc * 32 + 4 * fq;
        const float* bp = (u.pm < split) ? base0 + (size_t)u.pm * BM * DM : base1 + (size_t)(u.pm - split) * BM * DM;
        float* op = out + (size_t)u.pm * BM * DM; const float* gp = gate + (size_t)(u.pm >> 3) * NMOD + col0;
        f32x4 gv[2][2];
#pragma unroll
        for (int bj = 0; bj < 2; ++bj)
#pragma unroll
            for (int n = 0; n < 2; ++n) gv[bj][n] = *(const f32x4*)(gp + bj * HALF + n * 16);
#pragma unroll
        for (int ai = 0; ai < 2; ++ai)
#pragma unroll
            for (int m = 0; m < 4; ++m) { const size_t off = (size_t)(rl0 + ai * HALF + m * 16) * DM + col0;
#pragma unroll
                for (int bj = 0; bj < 2; ++bj)
#pragma unroll
                    for (int n = 0; n < 2; ++n) { const f32x4 bs = *(const f32x4*)(bp + off + bj * HALF + n * 16); *(f32x4*)(op + off + bj * HALF + n * 16) = bs + gv[bj][n] * acc[ai][bj][m][n]; }
                asm volatile("" ::: "memory"); }
    }
};
struct EpiSwiGLU {
    static constexpr bool PERM = false;
    bf16_t* act;
    __device__ __forceinline__ void operator()(AccRef acc, const Unit& u, int wr, int wc, int fr, int fq) const {
        bf16_t* p0 = act + (size_t)(u.pm * BM + wr * 64 + fr) * DFF + u.pn * 128 + wc * 32 + 8 * fq;
#pragma unroll
        for (int ai = 0; ai < 2; ++ai)
#pragma unroll
            for (int m = 0; m < 4; ++m) { f32x4 o[2];
#pragma unroll
                for (int bj = 0; bj < 2; ++bj)
#pragma unroll
                    for (int j = 0; j < 4; ++j) { const float g = acc[ai][bj][m][0][j]; o[bj][j] = g * sigmoidf_(g) * acc[ai][bj][m][1][j]; }
                *(u32x4*)(p0 + (size_t)(ai * HALF + m * 16) * DFF) = pack8(o[0], o[1]); }
    }
};
}

struct Args {
    const float *xp, *xs, *cp, *cs, *w_mod, *b_mod, *g_mix, *w_in, *sink, *w_attn, *w_four, *w_gate, *b_gate, *w_out, *g_ffn, *w_up, *w_down, *g_final;
    float* out; unsigned char* ws;
};

struct SrcIdent { __device__ __forceinline__ int operator()(int R) const { return R; } };
struct SrcUp { __device__ __forceinline__ int operator()(int R) const {
    const int pn = R >> 8, r = R & 255, bj = r >> 7, wc = (r >> 5) & 3, n = (r >> 4) & 1, i = r & 15, fq = i >> 2, j = i & 3;
    return (n ? DFF : 0) + 128 * pn + 32 * wc + 8 * fq + 4 * bj + j; } };
template <class Src> __device__ __forceinline__ void transpose_item(const float* W, int ldw, int K, bf16_t* WT, int nrows, int row_off, const Src src, LAS float* scr, int item, int lane) {
    const int nblk = nrows / 32, kb = item / nblk, nb = item % nblk, k0 = 64 * kb, n0 = 32 * nb;
    const int sc = src(n0 + (lane & 31));
#pragma unroll 8
    for (int i = 0; i < 32; ++i) { const int kk = 2 * i + (lane >> 5); scr[kk * 33 + (lane & 31)] = W[(size_t)(k0 + kk) * ldw + sc]; }
    asm volatile("s_waitcnt lgkmcnt(0)" ::: "memory");
    const int c = lane & 7;
#pragma unroll
    for (int j = 0; j < 4; ++j) { const int n = (lane >> 3) + 8 * j; const LAS float* s = scr + (8 * c) * 33 + n;
        u32x4 o; o.x = cvt_pk_bf16(s[0 * 33], s[1 * 33]); o.y = cvt_pk_bf16(s[2 * 33], s[3 * 33]); o.z = cvt_pk_bf16(s[4 * 33], s[5 * 33]); o.w = cvt_pk_bf16(s[6 * 33], s[7 * 33]);
        *(u32x4*)(WT + (size_t)(row_off + n0 + n) * K + k0 + 8 * c) = o; }
    asm volatile("s_waitcnt lgkmcnt(0)" ::: "memory");
}

template <bool OUT_BF16, bool HAS_MOD>
__device__ __forceinline__ void norm_rows(const float* src0, const float* src1, const float* g, const float* mod_shift, const float* mod_scale, void* outp, int gw, int NGW, int lane) {
    for (int m = gw; m < MTOK; m += NGW) {
        const float* xr = (m < NPR) ? src0 + (size_t)m * DM : src1 + (size_t)(m - NPR) * DM;
        f32x4 v[8]; float ss = 0.f;
#pragma unroll
        for (int j = 0; j < 8; ++j) { v[j] = ((const f32x4*)xr)[lane + 64 * j]; ss += (v[j].x * v[j].x + v[j].y * v[j].y) + (v[j].z * v[j].z + v[j].w * v[j].w); }
        ss = wave_sum(ss);
        const float rstd = 1.0f / sqrtf(ss * (1.0f / DM) + RMS_EPS);
        const int b = m >> 11;
#pragma unroll
        for (int j = 0; j < 8; ++j) { const int col = 4 * lane + 256 * j;
            f32x4 y = v[j] * rstd * *(const f32x4*)(g + col);
            if (HAS_MOD) { const f32x4 sc = *(const f32x4*)(mod_scale + (size_t)b * NMOD + col), sh = *(const f32x4*)(mod_shift + (size_t)b * NMOD + col); y = y * (1.0f + sc) + sh; }
            if (OUT_BF16) { u32x2 w; w.x = cvt_pk_bf16(y.x, y.y); w.y = cvt_pk_bf16(y.z, y.w); *(u32x2*)((bf16_t*)outp + (size_t)m * DM + col) = w; }
            else *(f32x4*)((float*)outp + (size_t)m * DM + col) = y; }
    }
}

__device__ __forceinline__ void attn_phase(LAS unsigned char* lds, const bf16_t* QKV, bf16_t* AO, const float* sink, int G_, int c_) {
    const int tid = threadIdx.x, lane = tid & 63, wid = __builtin_amdgcn_readfirstlane(tid >> 6);
    const int r = lane & 31, h = lane >> 5, hg = wid >> 1, w2 = wid & 1;
    constexpr int KPB = 272, VPB = 136, CHB = 17408;
    LAS unsigned char* Kb = lds; LAS unsigned char* Vb = lds + 2 * CHB; LAS unsigned char* Ow = lds + 4 * CHB + wid * (32 * KPB);
    const float SC2 = 0.08838834764831845f * LOG2E;
    int cc = 0;
    for (int u = c_; u < NBATCH * 4 * 32; u += G_) {
        const int b = u >> 7, kvh = (u >> 5) & 3, qb = u & 31, a0 = qb * 64, q0 = a0 + 32 * w2, hq = kvh * 4 + hg;
        const float slope2 = exp2f(-0.5f * (float)(hq + 1)) * LOG2E, sink2 = sink[hq] * LOG2E;
        bf16x8 qf[8];
        { const bf16_t* qrow = QKV + (size_t)(b * SEQ + q0 + r) * 3072 + hq * 128 + 8 * h;
#pragma unroll
          for (int ks = 0; ks < 8; ++ks) qf[ks] = *(const bf16x8*)(qrow + 16 * ks); }
        f32x16 ot[4];
#pragma unroll
        for (int dt = 0; dt < 4; ++dt)
#pragma unroll
            for (int i = 0; i < 16; ++i) ot[dt][i] = 0.f;
        float m_run = sink2, l_run = 1.0f;
        const int jlo = (2 - qb) > 0 ? (2 - qb) : 0, jhi = (33 - qb) < 4 ? (33 - qb) : 4;
        u32x4 kreg[2], vreg[2];
        const int kp = tid & 31, dg = tid >> 5;
#define ATT_LOAD(j) do { const size_t tokb = (size_t)(b * SEQ + a0 - 128 + 64 * (j)); \
            _Pragma("unroll") for (int i = 0; i < 2; ++i) { const int p = tid + 512 * i; kreg[i] = *(const u32x4*)(QKV + (tokb + (p >> 4)) * 3072 + 2048 + kvh * 128 + (p & 15) * 8); } \
            _Pragma("unroll") for (int i = 0; i < 2; ++i) vreg[i] = *(const u32x4*)(QKV + (tokb + 2 * kp + i) * 3072 + 2560 + kvh * 128 + dg * 8); } while (0)
        ATT_LOAD(jlo);
        for (int j = jlo; j <= jhi; ++j, ++cc) {
            LAS unsigned char* Kc = Kb + (cc & 1) * CHB; LAS unsigned char* Vc = Vb + (cc & 1) * CHB;
#pragma unroll
            for (int i = 0; i < 2; ++i) { const int p = tid + 512 * i; *(LAS u32x4*)(Kc + (p >> 4) * KPB + (p & 15) * 16) = kreg[i]; }
#pragma unroll
            for (int w = 0; w < 4; ++w) { const unsigned x0 = vreg[0][w], x1 = vreg[1][w];
                *(LAS unsigned*)(Vc + (8 * dg + 2 * w) * VPB + kp * 4) = (x0 & 0xffffu) | (x1 << 16);
                *(LAS unsigned*)(Vc + (8 * dg + 2 * w + 1) * VPB + kp * 4) = (x0 >> 16) | (x1 & 0xffff0000u); }
            __syncthreads();
            if (j < jhi) ATT_LOAD(j + 1);
            f32x16 st[2];
#pragma unroll
            for (int kt = 0; kt < 2; ++kt) {
#pragma unroll
                for (int i = 0; i < 16; ++i) st[kt][i] = 0.f;
#pragma unroll
                for (int ks = 0; ks < 8; ++ks) { const bf16x8 a = *(const LAS bf16x8*)(Kc + (32 * kt + r) * KPB + (16 * ks + 8 * h) * 2); st[kt] = __builtin_amdgcn_mfma_f32_32x32x16_bf16(a, qf[ks], st[kt], 0, 0, 0); } }
            const int relb = (a0 - 128 + 64 * j + 4 * h) - (q0 + r);
            float mx = -INFINITY;
#pragma unroll
            for (int kt = 0; kt < 2; ++kt)
#pragma unroll
                for (int i = 0; i < 16; ++i) { const int rel = relb + 32 * kt + (i & 3) + 8 * (i >> 2); const int ar = rel < 0 ? -rel : rel;
                    float t = st[kt][i] * SC2 - slope2 * (float)ar; t = (ar <= 128) ? t : -INFINITY; st[kt][i] = t; mx = fmaxf(mx, t); }
            mx = fmaxf(mx, __shfl_xor(mx, 32));
            const float m_new = fmaxf(m_run, mx), alpha = __builtin_amdgcn_exp2f(m_run - m_new); m_run = m_new;
            float ls = 0.f;
#pragma unroll
            for (int kt = 0; kt < 2; ++kt)
#pragma unroll
                for (int i = 0; i < 16; ++i) { const float p = __builtin_amdgcn_exp2f(st[kt][i] - m_new); st[kt][i] = p; ls += p; }
            ls += __shfl_xor(ls, 32); l_run = l_run * alpha + ls;
#pragma unroll
            for (int dt = 0; dt < 4; ++dt)
#pragma unroll
                for (int i = 0; i < 16; ++i) ot[dt][i] *= alpha;
#pragma unroll
            for (int kt = 0; kt < 2; ++kt)
#pragma unroll
                for (int s = 0; s < 2; ++s) {
                    u32x4 pw; pw.x = cvt_pk_bf16(st[kt][8 * s + 0], st[kt][8 * s + 1]); pw.y = cvt_pk_bf16(st[kt][8 * s + 2], st[kt][8 * s + 3]); pw.z = cvt_pk_bf16(st[kt][8 * s + 4], st[kt][8 * s + 5]); pw.w = cvt_pk_bf16(st[kt][8 * s + 6], st[kt][8 * s + 7]);
                    asm volatile("s_nop 1" ::: "memory");
                    const bf16x8 pf = __builtin_bit_cast(bf16x8, pw);
#pragma unroll
                    for (int dt = 0; dt < 4; ++dt) { const LAS unsigned char* vp = Vc + (32 * dt + r) * VPB + (32 * kt + 16 * s + 4 * h) * 2;
                        const s16x4 lo = *(const LAS s16x4*)vp, hi = *(const LAS s16x4*)(vp + 16);
                        const bf16x8 a2 = __builtin_shufflevector(lo, hi, 0, 1, 2, 3, 4, 5, 6, 7);
                        ot[dt] = __builtin_amdgcn_mfma_f32_32x32x16_bf16(a2, pf, ot[dt], 0, 0, 0); } }
        }
#undef ATT_LOAD
        const float inv = 1.0f / l_run;
#pragma unroll
        for (int dt = 0; dt < 4; ++dt)
#pragma unroll
            for (int g4 = 0; g4 < 4; ++g4) { u32x2 w; w.x = cvt_pk_bf16(ot[dt][4 * g4] * inv, ot[dt][4 * g4 + 1] * inv); w.y = cvt_pk_bf16(ot[dt][4 * g4 + 2] * inv, ot[dt][4 * g4 + 3] * inv);
                *(LAS u32x2*)(Ow + r * KPB + (32 * dt + 8 * g4 + 4 * h) * 2) = w; }
        asm volatile("s_waitcnt lgkmcnt(0)" ::: "memory");
#pragma unroll
        for (int it = 0; it < 8; ++it) { const int row = it * 4 + (lane >> 4), c16 = lane & 15;
            const u32x4 v = *(const LAS u32x4*)(Ow + row * KPB + c16 * 16);
            *(u32x4*)(AO + (size_t)(b * SEQ + q0 + row) * DM + hq * 128 + c16 * 8) = v; }
        asm volatile("s_waitcnt lgkmcnt(0)" ::: "memory");
    }
    __syncthreads();
}

__global__ void __launch_bounds__(512, 2) fwd(Args a) {
    extern __shared__ __attribute__((aligned(16))) unsigned char lds_raw[];
    LAS unsigned char* lds = (LAS unsigned char*)lds_raw;
    cg::grid_group grid = cg::this_grid();
    const int tid = threadIdx.x, lane = tid & 63, wid = __builtin_amdgcn_readfirstlane(tid >> 6);
    const int G = gridDim.x, bx = blockIdx.x;
    const int gw = bx * NWAVES + wid, NGW = G * NWAVES;
    unsigned char* ws = a.ws;
    float* mod = (float*)(ws + WS_MOD);
    bf16_t* WinT = (bf16_t*)(ws + WS_WIN); bf16_t* WuT = (bf16_t*)(ws + WS_WU); bf16_t* WaT = (bf16_t*)(ws + WS_WA); bf16_t* WfT = (bf16_t*)(ws + WS_WF);
    bf16_t* WoT = (bf16_t*)(ws + WS_WO); bf16_t* WupT = (bf16_t*)(ws + WS_WUP); bf16_t* WdT = (bf16_t*)(ws + WS_WD); bf16_t* Ft = (bf16_t*)(ws + WS_FT);
    bf16_t* Hb = (bf16_t*)(ws + WS_H); bf16_t* QKV = (bf16_t*)(ws + WS_QKV); bf16_t* UT = (bf16_t*)(ws + WS_UT); bf16_t* AO = (bf16_t*)(ws + WS_AO); bf16_t* RE = (bf16_t*)(ws + WS_RE);
    bf16_t* TMP = (bf16_t*)(ws + WS_TMP); bf16_t* MERGED = (bf16_t*)(ws + WS_MERGED); bf16_t* ACT = (bf16_t*)(ws + WS_ACT);
    bf16_t* Gt = (bf16_t*)a.out;

    {
        LAS f32x2* tab = (LAS f32x2*)(lds + 131072);
        if (tid < 256) { float s, c; sincospif((float)tid * (1.0f / 128.0f), &s, &c); tab[tid] = (f32x2){c * 0.0625f, s * 0.0625f}; }
        __syncthreads();
        for (int jb = bx; jb < NMOD / 64; jb += G) {
            const int col = jb * 64 + lane;
            LAS float* sl = (LAS float*)(lds + wid * 16384);
            float acc[NBATCH];
#pragma unroll
            for (int b = 0; b < NBATCH; ++b) acc[b] = 0.f;
            for (int half = 0; half < 2; ++half) {
                const int k0 = wid * 256 + half * 128;
                for (int i = 0; i < 40; ++i) { const int e = lane + 64 * i, kk = e & 127, bb = e >> 7;
                    const float c = (bb < 4) ? a.cp[bb * DM + k0 + kk] : a.cs[(bb - 4) * DM + k0 + kk];
                    sl[kk * NBATCH + bb] = c / (1.0f + expf(-c)); }
                asm volatile("s_waitcnt lgkmcnt(0)" ::: "memory");
#pragma unroll 8
                for (int kk = 0; kk < 128; ++kk) { const float w = a.w_mod[(size_t)(k0 + kk) * NMOD + col];
#pragma unroll
                    for (int q = 0; q < 5; ++q) { const f32x4 s = *(const LAS f32x4*)(sl + kk * NBATCH + 4 * q);
                        acc[4 * q] += s.x * w; acc[4 * q + 1] += s.y * w; acc[4 * q + 2] += s.z * w; acc[4 * q + 3] += s.w * w; } }
                asm volatile("s_waitcnt lgkmcnt(0)" ::: "memory");
            }
            LAS float* red = (LAS float*)(lds + wid * 16384 + 10240);
#pragma unroll
            for (int b = 0; b < NBATCH; ++b) red[b * 64 + lane] = acc[b];
            __syncthreads();
            for (int e = tid; e < NBATCH * 64; e += 512) { const int b = e >> 6, l = e & 63; float s = a.b_mod[jb * 64 + l];
#pragma unroll
                for (int w = 0; w < 8; ++w) s += ((const LAS float*)(lds + w * 16384 + 10240))[b * 64 + l];
                mod[(size_t)b * NMOD + jb * 64 + l] = s; }
            __syncthreads();
        }
        if (wid < 4) {
            for (int f = bx * 4 + wid; f < 1024; f += G * 4) {
                const int g = f >> 8, k0 = (f & 255) * 8;
                LAS float* wl = (LAS float*)(lds + wid * 16384);
#pragma unroll
                for (int i = 0; i < 8; ++i) { const f32x4 v = *(const f32x4*)(a.w_in + (size_t)(k0 + i) * 4096 + 3072 + g * 256 + 4 * lane);
                    wl[(4 * lane + 0) * 8 + i] = v.x; wl[(4 * lane + 1) * 8 + i] = v.y; wl[(4 * lane + 2) * 8 + i] = v.z; wl[(4 * lane + 3) * 8 + i] = v.w; }
                asm volatile("s_waitcnt lgkmcnt(0)" ::: "memory");
                float ac[4][8], as[4][8];
#pragma unroll
                for (int q = 0; q < 4; ++q)
#pragma unroll
                    for (int i = 0; i < 8; ++i) { ac[q][i] = 0.f; as[q][i] = 0.f; }
                int idx0 = 0, idx1 = 0, idx2 = 0, idx3 = 0;
                for (int d = 0; d < 256; ++d) {
                    const f32x4 w0 = *(const LAS f32x4*)(wl + d * 8), w1 = *(const LAS f32x4*)(wl + d * 8 + 4);
                    const float wv[8] = {w0.x, w0.y, w0.z, w0.w, w1.x, w1.y, w1.z, w1.w};
                    const f32x2 t0 = tab[idx0], t1 = tab[idx1], t2 = tab[idx2], t3 = tab[idx3];
                    idx0 = (idx0 + lane) & 255; idx1 = (idx1 + lane + 64) & 255; idx2 = (idx2 + lane + 128) & 255; idx3 = (idx3 + lane + 192) & 255;
#pragma unroll
                    for (int i = 0; i < 8; ++i) { ac[0][i] += wv[i] * t0.x; as[0][i] += wv[i] * t0.y; ac[1][i] += wv[i] * t1.x; as[1][i] += wv[i] * t1.y;
                        ac[2][i] += wv[i] * t2.x; as[2][i] += wv[i] * t2.y; ac[3][i] += wv[i] * t3.x; as[3][i] += wv[i] * t3.y; }
                }
#pragma unroll
                for (int q = 0; q < 4; ++q) { const int cp_ = lane + 64 * q;
                    u32x4 oc, os; oc.x = cvt_pk_bf16(ac[q][0], ac[q][1]); oc.y = cvt_pk_bf16(ac[q][2], ac[q][3]); oc.z = cvt_pk_bf16(ac[q][4], ac[q][5]); oc.w = cvt_pk_bf16(ac[q][6], ac[q][7]);
                    os.x = cvt_pk_bf16(as[q][0], as[q][1]); os.y = cvt_pk_bf16(as[q][2], as[q][3]); os.z = cvt_pk_bf16(as[q][4], as[q][5]); os.w = cvt_pk_bf16(as[q][6], as[q][7]);
                    *(u32x4*)(WuT + (size_t)(g * 256 + cp_) * DM + k0) = oc; *(u32x4*)(WuT + (size_t)(1024 + g * 256 + cp_) * DM + k0) = os; }
                asm volatile("s_waitcnt lgkmcnt(0)" ::: "memory");
            }
        }
        {
            constexpr int I1 = 32 * 96, I2 = 32 * 128, I3 = 32 * 64, I4 = 16 * 64, I5 = 32 * 64, I6 = 32 * 352, I7 = 88 * 64, I8 = 2048;
            constexpr int NITEMS = I1 + I2 + I3 + I4 + I5 + I6 + I7 + I8;
            unsigned* ctr = (unsigned*)(ws + WS_CTL);
            LAS float* scr = (LAS float*)(lds + wid * 16384);
            for (;;) {
                int it = 0; if (lane == 0) it = (int)atomicAdd(ctr, 1u);
                it = __builtin_amdgcn_readfirstlane(it);
                if (it >= NITEMS) break;
                int rr = it;
                if (rr < I1) { transpose_item(a.w_in, 4096, DM, WinT, 3072, 0, SrcIdent{}, scr, rr, lane); continue; } rr -= I1;
                if (rr < I2) { transpose_item(a.w_gate, 4096, DM, WinT, 4096, 3072, SrcIdent{}, scr, rr, lane); continue; } rr -= I2;
                if (rr < I3) { transpose_item(a.w_attn, DM, DM, WaT, DM, 0, SrcIdent{}, scr, rr, lane); continue; } rr -= I3;
                if (rr < I4) { transpose_item(a.w_four, DM, 1024, WfT, DM, 0, SrcIdent{}, scr, rr, lane); continue; } rr -= I4;
                if (rr < I5) { transpose_item(a.w_out, DM, DM, WoT, DM, 0, SrcIdent{}, scr, rr, lane); continue; } rr -= I5;
                if (rr < I6) { transpose_item(a.w_up, 2 * DFF, DM, WupT, 2 * DFF, 0, SrcUp{}, scr, rr, lane); continue; } rr -= I6;
                if (rr < I7) { transpose_item(a.w_down, DM, DFF, WdT, DM, 0, SrcIdent{}, scr, rr, lane); continue; } rr -= I7;
#pragma unroll 1
                for (int i = 0; i < 8; ++i) { const int piece = rr * 512 + lane + 64 * i, e0 = piece * 8, t = e0 >> 12, k = e0 & 4095, part = k >> 11;
                    float v[8];
#pragma unroll
                    for (int jj = 0; jj < 8; ++jj) { const int s_ = (k + jj) & 2047, idx = (t * s_) & 2047; float sn, cs; sincospif((float)idx * (1.0f / 1024.0f), &sn, &cs); v[jj] = (part ? -sn : cs) * 0.022097086912079608f; }
                    u32x4 o; o.x = cvt_pk_bf16(v[0], v[1]); o.y = cvt_pk_bf16(v[2], v[3]); o.z = cvt_pk_bf16(v[4], v[5]); o.w = cvt_pk_bf16(v[6], v[7]);
                    *(u32x4*)(Ft + (size_t)e0) = o; }
            }
        }
    }
    grid.sync();

    norm_rows<true, true>(a.xp, a.xs, a.g_mix, mod + 0 * DM, mod + 1 * DM, Hb, gw, NGW, lane);
    grid.sync();

    { pg8::Order S; S.init(MTOK / 256, 28, G, bx, 0); pg8::EpiQKVG E{QKV, Gt, a.b_gate};
      pg8::gemm_phase<pg8::EpiQKVG, true, true>(lds, Hb, WinT, DM, S, E); }
    { pg8::Order S; S.init(8, MTOK / 256, G, bx, 0); pg8::EpiBf16 E{UT, 4096, 1};
      pg8::gemm_phase<pg8::EpiBf16, true, true>(lds, WuT, Hb, DM, S, E); }
    grid.sync();

    attn_phase(lds, QKV, AO, a.sink, G, bx);
    { pg8::Order S; S.init(NBATCH * 8, 4, G, bx, 1); pg8::EpiBf16 E{RE, 1024, 0};
      pg8::gemm_phase<pg8::EpiBf16, true, true>(lds, Ft, UT, 4096, S, E); }
    grid.sync();

    { pg8::Order S; S.init(MTOK / 256, 8, G, bx, 0); pg8::EpiMerge<0> E{Gt, nullptr, TMP};
      pg8::gemm_phase<pg8::EpiMerge<0>, true, true>(lds, AO, WaT, DM, S, E); }
    grid.sync();
    { pg8::Order S; S.init(MTOK / 256, 8, G, bx, 0); pg8::EpiMerge<1> E{Gt, TMP, MERGED};
      pg8::gemm_phase<pg8::EpiMerge<1>, true, true>(lds, RE, WfT, 1024, S, E); }
    grid.sync();

    { pg8::Order S; S.init(MTOK / 256, 8, G, bx, 0); pg8::EpiRes E{a.xp, a.xs, NPR / 256, mod + 2 * DM, a.out};
      pg8::gemm_phase<pg8::EpiRes, true, true>(lds, MERGED, WoT, DM, S, E); }
    grid.sync();

    norm_rows<true, true>(a.out, a.out + (size_t)NPR * DM, a.g_ffn, mod + 3 * DM, mod + 4 * DM, Hb, gw, NGW, lane);
    grid.sync();

    { pg8::Order S; S.init(MTOK / 256, 44, G, bx, 0); pg8::EpiSwiGLU E{ACT};
      pg8::gemm_phase<pg8::EpiSwiGLU, true, true>(lds, Hb, WupT, DM, S, E); }
    grid.sync();

    { pg8::Order S; S.init(MTOK / 256, 8, G, bx, 0); pg8::EpiRes E{a.out, a.out, 1 << 30, mod + 5 * DM, a.out};
      pg8::gemm_phase<pg8::EpiRes, true, true>(lds, ACT, WdT, DFF, S, E); }
    grid.sync();

    norm_rows<false, false>(a.out, a.out + (size_t)NPR * DM, a.g_final, nullptr, nullptr, a.out, gw, NGW, lane);
}

extern "C" void kernel_launch(void* const* d_in, const int* in_sizes, int n_in, void* d_out, int out_size, void* d_ws, size_t ws_size, hipStream_t stream) {
    static int grid = 0;
    if (grid == 0) {
        if (n_in != 18 || out_size != MTOK * DM || ws_size < WS_END) { fprintf(stderr, "kernel_launch: unexpected problem (n_in %d, out %d, ws %zu < %zu)\n", n_in, out_size, ws_size, (size_t)WS_END); grid = -1; return; }
        int dev = 0, cus = 0, per_cu = 0;
        (void)hipGetDevice(&dev); (void)hipDeviceGetAttribute(&cus, hipDeviceAttributeMultiprocessorCount, dev);
        if (hipFuncSetAttribute((const void*)fwd, hipFuncAttributeMaxDynamicSharedMemorySize, LDS_BYTES) != hipSuccess) { fprintf(stderr, "kernel_launch: hipFuncSetAttribute failed\n"); grid = -1; return; }
        if (hipOccupancyMaxActiveBlocksPerMultiprocessor(&per_cu, (const void*)fwd, NWAVES * 64, LDS_BYTES) != hipSuccess || per_cu < 1) { fprintf(stderr, "kernel_launch: occupancy query says %d blocks/CU\n", per_cu); per_cu = 1; }
        (void)hipGetLastError();
        grid = cus * per_cu;
    }
    if (grid < 0) return;
    (void)hipMemsetAsync((char*)d_ws + WS_CTL, 0, 256, stream);
    Args a{};
    a.xp = (const float*)d_in[0]; a.xs = (const float*)d_in[1]; a.cp = (const float*)d_in[2]; a.cs = (const float*)d_in[3]; a.w_mod = (const float*)d_in[4]; a.b_mod = (const float*)d_in[5];
    a.g_mix = (const float*)d_in[6]; a.w_in = (const float*)d_in[7]; a.sink = (const float*)d_in[8]; a.w_attn = (const float*)d_in[9]; a.w_four = (const float*)d_in[10]; a.w_gate = (const float*)d_in[11];
    a.b_gate = (const float*)d_in[12]; a.w_out = (const float*)d_in[13]; a.g_ffn = (const float*)d_in[14]; a.w_up = (const float*)d_in[15]; a.w_down = (const float*)d_in[16]; a.g_final = (const float*)d_in[17];
    a.out = (float*)d_out; a.ws = (unsigned char*)d_ws;
    void* args[] = {&a};
    const hipError_t e = hipLaunchCooperativeKernel((void*)fwd, dim3(grid), dim3(NWAVES * 64), args, LDS_BYTES, stream);
    if (e != hipSuccess) fprintf(stderr, "kernel_launch: cooperative launch failed: %s (grid %d)\n", hipGetErrorString(e), grid);
}
```

```cpp
#include <hip/hip_runtime.h>
#include <hip/hip_cooperative_groups.h>
#include <cstdio>
#include <cstdint>
namespace cg = cooperative_groups;

#define LAS __attribute__((address_space(3)))
typedef unsigned short bf16_t;
typedef short bf16x8 __attribute__((ext_vector_type(8)));
typedef short s16x4 __attribute__((ext_vector_type(4)));
typedef float f32x4 __attribute__((ext_vector_type(4)));
typedef float f32x2 __attribute__((ext_vector_type(2)));
typedef float f32x16 __attribute__((ext_vector_type(16)));
typedef unsigned u32x4 __attribute__((ext_vector_type(4)));
typedef unsigned u32x2 __attribute__((ext_vector_type(2)));
typedef int i32x4 __attribute__((ext_vector_type(4)));
typedef int i32x8 __attribute__((ext_vector_type(8)));

constexpr int DM = 2048, SEQ = 2048, NBATCH = 20, MTOK = NBATCH * SEQ, NPR = 4 * SEQ;
constexpr int DFF = 5632, NMOD = 6 * DM;
constexpr float RMS_EPS = 1e-6f;
constexpr float LOG2E = 1.4426950408889634f;
constexpr size_t MiB = 1u << 20;
constexpr size_t WS_CTL = 0, WS_BAR = 4096, CTL_BYTES = 32768, WS_MOD = 32768;
constexpr size_t WS_WIN = 1 * MiB, WS_WU = 29 * MiB, WS_WA = 37 * MiB, WS_WF = 45 * MiB, WS_WO = 49 * MiB, WS_WUP = 57 * MiB, WS_WD = 101 * MiB, WS_FT = 123 * MiB;
constexpr size_t WS_H = 140 * MiB, WS_QKV = 300 * MiB, WS_UT = 540 * MiB, WS_AO = 700 * MiB, WS_RE = 860 * MiB, WS_U1024 = 940 * MiB, WS_END = 941 * MiB;
constexpr size_t WS_X1B = 740 * MiB;
constexpr size_t WS_H8 = 620 * MiB;
constexpr size_t WS_WG8 = WS_WIN + 12 * MiB;
constexpr size_t WS_HF = WS_AO, WS_V = WS_UT;
constexpr size_t WS_TMP = WS_H, WS_MERGED = WS_QKV, WS_ACT = WS_QKV;
constexpr int LDS_BYTES = 147456;
constexpr int NWAVES = 8;
#ifndef PROBE
#define PROBE -1
#endif
#define PH_BEGIN(k) do { if (PROBE >= 0 && ((PROBE >> (k)) & 1) && bx == 0 && tid == 0) pstamp[0] = __builtin_amdgcn_s_memrealtime(); } while (0)
#define PH_END(k)   do { if (PROBE >= 0 && ((PROBE >> (k)) & 1) && bx == 0 && tid == 0) pstamp[1] += __builtin_amdgcn_s_memrealtime() - pstamp[0]; } while (0)

__device__ __forceinline__ unsigned cvt_pk_bf16(float lo, float hi) { unsigned r; asm volatile("v_cvt_pk_bf16_f32 %0, %1, %2" : "=v"(r) : "v"(lo), "v"(hi)); return r; }
__device__ __forceinline__ unsigned pk_fp8x4(float a, float b, float c, float d) {
    a = fminf(fmaxf(a, -448.f), 448.f); b = fminf(fmaxf(b, -448.f), 448.f); c = fminf(fmaxf(c, -448.f), 448.f); d = fminf(fmaxf(d, -448.f), 448.f);
    int w = 0; w = __builtin_amdgcn_cvt_pk_fp8_f32(a, b, w, false); w = __builtin_amdgcn_cvt_pk_fp8_f32(c, d, w, true); return (unsigned)w; }
__device__ __forceinline__ float bf_lo(unsigned w) { return __uint_as_float(w << 16); }
__device__ __forceinline__ float bf_hi(unsigned w) { return __uint_as_float(w & 0xffff0000u); }
__device__ __forceinline__ float sigmoidf_(float v) { return __builtin_amdgcn_rcpf(1.0f + __builtin_amdgcn_exp2f(-v * LOG2E)); }
__device__ __forceinline__ float wave_sum(float v) {
#pragma unroll
    for (int o = 1; o < 64; o <<= 1) v += __shfl_xor(v, o);
    return v;
}


#define XB_TMO      128
#define XB_XCNT(j)  (256  + 64 * (j))
#define XB_XSUB(j)  (1280 + 64 * (j))
#define XB_XGEN(j)  (2304 + 64 * (j))
#define XB_TOP      3328
#define XB_TOPGEN   3392
#define XCD_BAR_WORDS 3456
#define XB_SPIN_CAP (1u << 22)
__device__ __forceinline__ unsigned xb_ld(unsigned* p)              { return __hip_atomic_load(p, __ATOMIC_RELAXED, __HIP_MEMORY_SCOPE_AGENT); }
__device__ __forceinline__ unsigned xb_add(unsigned* p, unsigned v) { return __hip_atomic_fetch_add(p, v, __ATOMIC_RELAXED, __HIP_MEMORY_SCOPE_AGENT); }
__device__ __forceinline__ unsigned xb_xcc_id() { return (unsigned)__builtin_amdgcn_s_getreg((3 << 11) | 20) & 0xFu; }
#define XB_SPIN(cond, bar) do { unsigned _sp = 0; while (cond) { __builtin_amdgcn_s_sleep(1); \
    if ((++_sp & 255u) == 0u) { if (xb_ld(&(bar)[XB_TMO])) break; if (_sp > XB_SPIN_CAP) { atomicAdd(&(bar)[XB_TMO], 1u); break; } } } } while (0)
struct XcdBarrier { unsigned* bar; unsigned x; volatile LAS unsigned* st; };
__device__ __forceinline__ XcdBarrier xcd_barrier_post(unsigned* bar, volatile LAS unsigned* st) {
    XcdBarrier b; b.bar = bar; b.x = xb_xcc_id(); b.st = st;
    if (threadIdx.x == 0) (void)xb_add(&bar[XB_XCNT(b.x)], 1u);
    return b;
}
__device__ __forceinline__ void xcd_barrier_complete(unsigned* bar, unsigned x, unsigned& nloc, unsigned& nx) {
    const unsigned G = gridDim.x * gridDim.y * gridDim.z;
    unsigned sum, cnt, mine, sp = 0u;
    for (;;) {
        sum = 0u; cnt = 0u; mine = 0u;
#pragma unroll
        for (unsigned j = 0; j < 16; ++j) { const unsigned c = xb_ld(&bar[XB_XCNT(j)]); sum += c; cnt += (c > 0u) ? 1u : 0u; mine = (j == x) ? c : mine; }
        if (sum == G) break;
        __builtin_amdgcn_s_sleep(1);
        if ((++sp & 255u) == 0u) { if (xb_ld(&bar[XB_TMO])) break; if (sp > XB_SPIN_CAP) { atomicAdd(&bar[XB_TMO], 1u); break; } }
    }
    nloc = mine > 0u ? mine : 1u; nx = cnt > 0u ? cnt : 1u;
}
__device__ __forceinline__ void xcd_barrier(const XcdBarrier& b) {
    asm volatile("s_waitcnt vmcnt(0)" ::: "memory");
    __syncthreads();
    if (threadIdx.x == 0) {
        unsigned* bar = b.bar;
        __builtin_amdgcn_s_waitcnt(0);
        unsigned nloc = b.st[0], nx = b.st[1];
        if (nloc == 0u) { xcd_barrier_complete(bar, b.x, nloc, nx); b.st[0] = nloc; b.st[1] = nx; }
        const unsigned old = xb_add(&bar[XB_XSUB(b.x)], 1u);
        const unsigned gen = old / nloc;
        if (old + 1u == (gen + 1u) * nloc) {
            __builtin_amdgcn_fence(__ATOMIC_RELEASE, "agent");
            asm volatile("s_waitcnt vmcnt(0)" ::: "memory");
            const unsigned og = xb_add(&bar[XB_TOP], 1u);
            const unsigned tg = og / nx;
            if (og + 1u == (tg + 1u) * nx) xb_add(&bar[XB_TOPGEN], 1u);
            else XB_SPIN(xb_ld(&bar[XB_TOPGEN]) == tg, bar);
            __builtin_amdgcn_fence(__ATOMIC_ACQUIRE, "agent");
            xb_add(&bar[XB_XGEN(b.x)], 1u);
            asm volatile("s_waitcnt vmcnt(0)" ::: "memory");
        } else {
            XB_SPIN(xb_ld(&bar[XB_XGEN(b.x)]) == gen, bar);
            __builtin_amdgcn_fence(__ATOMIC_ACQUIRE, "agent");
            asm volatile("s_waitcnt vmcnt(0)" ::: "memory");
        }
    }
    __syncthreads();
}

namespace pg8 {
constexpr int BM = 256, BK = 64, HALF = 128, HTB = HALF * BK * 2, STAGE_BYTES = 8 * HTB, NXCD = 8, WGM = 8;
__host__ __device__ __forceinline__ int lds_byte(int r, int c) { const int st = (r >> 4) * 2 + (c >> 5), rr = r & 15, cc = c & 31, ob = rr * 64 + cc * 2; return st * 1024 + (ob ^ (((ob >> 9) & 1) << 5)); }
__host__ __device__ __forceinline__ void stage_rc(int b, int& R, int& C) { const int st = b / 1024, sb = b % 1024, swz = sb ^ (((sb >> 9) & 1) << 5); R = (st >> 1) * 16 + swz / 64; C = (st & 1) * 32 + (swz % 64) / 2; }
__host__ __device__ __forceinline__ int perm32(int rho) { const int n = rho >> 4, i = rho & 15; return 8 * (i >> 2) + 4 * n + (i & 3); }

struct Unit { int pm, pn, ta, tb, part; };
struct Order {
    int nM, nN, nwg, G, c, dft;
    __device__ void init(int nM_, int nN_, int G_, int c_, int dft_) { nM = nM_; nN = nN_; nwg = nM * nN; G = G_; c = c_; dft = dft_; }
    __device__ bool next(int i, Unit& u) const {
        const long L = (long)((dft == 4) ? (i >> 1) : i) * G + c; if (L >= nwg) return false;
        u.part = 0;
        int wgid = (int)L; { const int q = nwg / NXCD, r = nwg % NXCD, xcd = wgid % NXCD, off = wgid / NXCD; wgid = (xcd < r ? xcd * (q + 1) : r * (q + 1) + (xcd - r) * q) + off; }
        if (dft == 2) { const int b = wgid >> 5, r = wgid & 31, half = r >> 4, jt = (r >> 2) & 3, pmi = r & 3;
            u.pm = b * 4 + pmi; u.pn = half * 4 + jt; u.ta = half * 4 + pmi; u.tb = b * 8 + half * 4 + jt; return true; }
        if (dft == 4) { const int part = i & 1, b = wgid >> 4, tm = (wgid >> 2) & 3, tn = wgid & 3;
            u.pm = b * 4 + tm; u.pn = tn; u.ta = part * 4 + tm; u.tb = part * 80 + b * 4 + tn; u.part = part; return true; }
        const int nig = WGM * nN, gid = wgid / nig, fm = gid * WGM, gsz = (nM - fm) < WGM ? (nM - fm) : WGM;
        u.pm = fm + ((wgid % nig) % gsz); u.pn = (wgid % nig) / gsz;
        if (dft == 5) { u.pn += 12; u.ta = u.pm; u.tb = u.pn; return true; }
        u.ta = dft ? (u.pm & 7) : u.pm; u.tb = dft ? ((u.pm >> 3) * 4 + u.pn) : u.pn;
        return true;
    }
};

template <class Epi, bool ALIGN_EPI, bool SP2, bool F8 = false>
__device__ __forceinline__ void gemm_phase(LAS unsigned char* lds, const bf16_t* gA, const bf16_t* gBt, const int K, const Order& S, const Epi& E) {
    int tid_ = threadIdx.x; asm volatile("" : "+v"(tid_));
    const int tid = tid_, wid = __builtin_amdgcn_readfirstlane(tid >> 6), lane = tid & 63, wr = wid >> 2, wc = wid & 3, fr = lane & 15, fq = lane >> 4;
    const int nt = K / BK;
    unsigned voffA, voffB;
    { int R, C; stage_rc(tid * 16, R, C); const int Rb = Epi::PERM ? ((R & ~31) + perm32(R & 31)) : R; voffA = (unsigned)(R * K + C) * 2u; voffB = (unsigned)(Rb * K + C) * 2u; }
    const size_t rstep = (size_t)64 * K * 2;
    const size_t kstep = (size_t)(BK * 2);
    const size_t hstep = (size_t)HALF * K * 2;
    const size_t tstep = 2 * hstep;
    const unsigned ldsw = (unsigned)wid * 1024u;
    const int aoff = lds_byte(wr * 64 + fr, fq * 8), boff = lds_byte(wc * 32 + fr, fq * 8);
#define PG8_SA(b, h) (((b) * 2 + (h)) * HTB)
#define PG8_SB(b, h) ((4 + (b) * 2 + (h)) * HTB)
#define PG8_STAGE(bufoff, gbase, voff) do { _Pragma("unroll") for (int _i = 0; _i < 2; ++_i) { unsigned _vo = (voff); asm volatile("" : "+v"(_vo));     \
        __builtin_amdgcn_global_load_lds((const unsigned*)((const char*)(gbase) + (size_t)_i * rstep + _vo), (LAS unsigned*)(lds + (bufoff) + ldsw + _i * 8192), 16, 0, 0); } } while (0)
#define PG8_LDA(dst, b, h) do { _Pragma("unroll") for (int m = 0; m < 4; ++m) dst[m] = __builtin_shufflevector(*(const LAS i32x4*)(lds + PG8_SA(b, h) + aoff + m * 2048), *(const LAS i32x4*)(lds + PG8_SA(b, h) + aoff + m * 2048 + 1024), 0, 1, 2, 3, 4, 5, 6, 7); } while (0)
#define PG8_LDB(dst, b, h) do { _Pragma("unroll") for (int n = 0; n < 2; ++n) dst[n] = __builtin_shufflevector(*(const LAS i32x4*)(lds + PG8_SB(b, h) + boff + n * 2048), *(const LAS i32x4*)(lds + PG8_SB(b, h) + boff + n * 2048 + 1024), 0, 1, 2, 3, 4, 5, 6, 7); } while (0)
#define PG8_HALF(v, k) __builtin_bit_cast(bf16x8, (k) ? __builtin_shufflevector(v, v, 4, 5, 6, 7) : __builtin_shufflevector(v, v, 0, 1, 2, 3))
#define PG8_MMA(ai, bj, At, Bt) do { __builtin_amdgcn_s_setprio(1); _Pragma("unroll") for (int m = 0; m < 4; ++m) _Pragma("unroll") for (int n = 0; n < 2; ++n) _Pragma("unroll") for (int k = 0; k < 2; ++k) \
        acc[ai][bj][m][n] = __builtin_amdgcn_mfma_f32_16x16x32_bf16(PG8_HALF(Bt[n], k), PG8_HALF(At[m], k), acc[ai][bj][m][n], 0, 0, 0); __builtin_amdgcn_s_setprio(0); } while (0)
#define PG8_MMA8(ai, bj, At, Bt) do { __builtin_amdgcn_s_setprio(1); _Pragma("unroll") for (int m = 0; m < 4; ++m) _Pragma("unroll") for (int n = 0; n < 2; ++n) \
        acc[ai][bj][m][n] = __builtin_amdgcn_mfma_scale_f32_16x16x128_f8f6f4(Bt[n], At[m], acc[ai][bj][m][n], 0, 0, 0, 0x7f7f7f7f, 0, 0x7f7f7f7f); __builtin_amdgcn_s_setprio(0); } while (0)
#define PG8_MM(ai, bj, At, Bt) do { if constexpr (F8) PG8_MMA8(ai, bj, At, Bt); else PG8_MMA(ai, bj, At, Bt); } while (0)
#define PG8_WAIT_V(n) asm volatile("s_waitcnt vmcnt(" #n ")" ::: "memory")
#define PG8_WAIT_L(n) asm volatile("s_waitcnt lgkmcnt(" #n ")" ::: "memory")
#define PG8_BAR __builtin_amdgcn_s_barrier()
#define PG8_SCHED __builtin_amdgcn_sched_barrier(0)
    Unit cur, nxt; int ui = 0;
    if (!S.next(0, cur)) return;
    f32x4 acc[2][2][4][2];
#pragma unroll
    for (int a = 0; a < 2; ++a)
#pragma unroll
        for (int b = 0; b < 2; ++b)
#pragma unroll
            for (int m = 0; m < 4; ++m)
#pragma unroll
                for (int n = 0; n < 2; ++n) acc[a][b][m][n] = (f32x4){0.f, 0.f, 0.f, 0.f};
    i32x8 At[4], B0[2], B1[2];
    const char* cA = (const char*)gA + (size_t)cur.ta * tstep; const char* cB = (const char*)gBt + (size_t)cur.tb * tstep;
    if constexpr (SP2) {
        PG8_STAGE(PG8_SB(0, 0), cB, voffB); PG8_STAGE(PG8_SB(0, 1), cB + hstep, voffB); PG8_STAGE(PG8_SA(0, 0), cA, voffA); PG8_STAGE(PG8_SA(0, 1), cA + hstep, voffA);
        if (wr == 1) PG8_BAR;
        PG8_WAIT_V(2); PG8_BAR;
        PG8_STAGE(PG8_SB(1, 0), cB + kstep, voffB); PG8_STAGE(PG8_SA(1, 0), cA + kstep, voffA); PG8_STAGE(PG8_SB(1, 1), cB + hstep + kstep, voffB);
        PG8_WAIT_V(6); PG8_BAR;
    } else {
        PG8_STAGE(PG8_SB(0, 0), cB, voffB); PG8_STAGE(PG8_SA(0, 0), cA, voffA); PG8_STAGE(PG8_SB(0, 1), cB + hstep, voffB); PG8_STAGE(PG8_SA(0, 1), cA + hstep, voffA);
        if (wr == 1) PG8_BAR;
        PG8_WAIT_V(4); PG8_BAR;
        PG8_STAGE(PG8_SB(1, 0), cB + kstep, voffB); PG8_STAGE(PG8_SA(1, 0), cA + kstep, voffA); PG8_STAGE(PG8_SB(1, 1), cB + hstep + kstep, voffB);
        PG8_WAIT_V(6); PG8_BAR;
    }
    for (;;) {
        const bool has_next = S.next(ui + 1, nxt);
        const char* nA = has_next ? (const char*)gA + (size_t)nxt.ta * tstep : cA; const char* nB = has_next ? (const char*)gBt + (size_t)nxt.tb * tstep : cB;
        for (int t = 0; t < nt; t += 2) {
            const bool last = (t == nt - 2);
            const char* a1 = cA + (size_t)(t + 1) * kstep;
            const char* a2 = last ? nA : cA + (size_t)(t + 2) * kstep; const char* b2 = last ? nB : cB + (size_t)(t + 2) * kstep;
            const char* a3 = a2 + kstep; const char* b3 = b2 + kstep;
            if constexpr (SP2) {
            PG8_LDB(B0, 0, 0); PG8_LDB(B1, 0, 1); PG8_SCHED; PG8_LDA(At, 0, 0); PG8_STAGE(PG8_SA(1, 1), a1 + hstep, voffA);
            PG8_WAIT_V(8); PG8_WAIT_L(0); PG8_BAR; PG8_MM(0, 0, At, B0); PG8_MM(0, 1, At, B1); PG8_BAR; PG8_SCHED;
            PG8_LDA(At, 0, 1); PG8_STAGE(PG8_SB(0, 0), b2, voffB); PG8_STAGE(PG8_SB(0, 1), b2 + hstep, voffB); PG8_STAGE(PG8_SA(0, 0), a2, voffA);
            PG8_WAIT_V(8); PG8_WAIT_L(0); PG8_BAR; PG8_MM(1, 0, At, B0); PG8_MM(1, 1, At, B1); PG8_BAR; PG8_SCHED;
            PG8_LDB(B0, 1, 0); PG8_LDB(B1, 1, 1); PG8_SCHED; PG8_LDA(At, 1, 0); PG8_STAGE(PG8_SA(0, 1), a2 + hstep, voffA);
            PG8_WAIT_V(8); PG8_WAIT_L(0); PG8_BAR; PG8_MM(0, 0, At, B0); PG8_MM(0, 1, At, B1); PG8_BAR; PG8_SCHED;
            PG8_LDA(At, 1, 1); PG8_STAGE(PG8_SB(1, 0), b3, voffB); PG8_STAGE(PG8_SB(1, 1), b3 + hstep, voffB); PG8_STAGE(PG8_SA(1, 0), a3, voffA);
            PG8_WAIT_V(8); PG8_WAIT_L(0); PG8_BAR; PG8_MM(1, 0, At, B0); PG8_MM(1, 1, At, B1); PG8_BAR; PG8_SCHED;
            } else {
            PG8_LDB(B0, 0, 0); PG8_SCHED; PG8_LDA(At, 0, 0); PG8_STAGE(PG8_SA(1, 1), a1 + hstep, voffA);
            PG8_WAIT_L(8); PG8_BAR; PG8_WAIT_L(0); PG8_MM(0, 0, At, B0); PG8_BAR; PG8_SCHED;
            PG8_LDB(B1, 0, 1); PG8_STAGE(PG8_SB(0, 0), b2, voffB);
            PG8_BAR; PG8_WAIT_L(0); PG8_MM(0, 1, At, B1); PG8_BAR;
            PG8_LDA(At, 0, 1); PG8_STAGE(PG8_SA(0, 0), a2, voffA);
            PG8_BAR; PG8_WAIT_L(0); PG8_MM(1, 0, At, B0); PG8_BAR; PG8_SCHED;
            PG8_STAGE(PG8_SB(0, 1), b2 + hstep, voffB);
            PG8_WAIT_V(6); PG8_BAR; PG8_MM(1, 1, At, B1); PG8_BAR;
            PG8_LDB(B0, 1, 0); PG8_SCHED; PG8_LDA(At, 1, 0); PG8_STAGE(PG8_SA(0, 1), a2 + hstep, voffA);
            PG8_WAIT_L(8); PG8_BAR; PG8_WAIT_L(0); PG8_MM(0, 0, At, B0); PG8_BAR; PG8_SCHED;
            PG8_LDB(B1, 1, 1); PG8_STAGE(PG8_SB(1, 0), b3, voffB);
            PG8_BAR; PG8_WAIT_L(0); PG8_MM(0, 1, At, B1); PG8_BAR;
            PG8_LDA(At, 1, 1); PG8_STAGE(PG8_SA(1, 0), a3, voffA);
            PG8_BAR; PG8_WAIT_L(0); PG8_MM(1, 0, At, B0); PG8_BAR; PG8_SCHED;
            PG8_STAGE(PG8_SB(1, 1), b3 + hstep, voffB);
            PG8_WAIT_V(6); PG8_BAR; PG8_MM(1, 1, At, B1); PG8_BAR;
            }
        }
        if constexpr (ALIGN_EPI) { if (wr == 0) PG8_BAR; }
        E(acc, cur, wr, wc, fr, fq);
        if (!has_next) break;
#pragma unroll
        for (int a = 0; a < 2; ++a)
#pragma unroll
            for (int b = 0; b < 2; ++b)
#pragma unroll
                for (int m = 0; m < 4; ++m)
#pragma unroll
                    for (int n = 0; n < 2; ++n) acc[a][b][m][n] = (f32x4){0.f, 0.f, 0.f, 0.f};
        cur = nxt; cA = nA; cB = nB; ++ui;
        if constexpr (ALIGN_EPI) { if (wr == 1) PG8_BAR; }
    }
    PG8_WAIT_V(0);
    if constexpr (!ALIGN_EPI) { if (wr == 0) PG8_BAR; }
    PG8_BAR;
#undef PG8_SA
#undef PG8_SB
#undef PG8_STAGE
#undef PG8_LDA
#undef PG8_LDB
#undef PG8_MMA
#undef PG8_HALF
#undef PG8_MMA8
#undef PG8_MM
#undef PG8_WAIT_V
#undef PG8_WAIT_L
#undef PG8_BAR
#undef PG8_SCHED
}

typedef const f32x4 (&AccRef)[2][2][4][2];
__device__ __forceinline__ u32x4 pack8(f32x4 v0, f32x4 v1) { u32x4 w; w.x = cvt_pk_bf16(v0[0], v0[1]); w.y = cvt_pk_bf16(v0[2], v0[3]); w.z = cvt_pk_bf16(v1[0], v1[1]); w.w = cvt_pk_bf16(v1[2], v1[3]); return w; }

struct EpiQKVG {
    static constexpr bool PERM = true;
    bf16_t* qkv; bf16_t* gate; const float* bgate; float gsc;
    __device__ __forceinline__ void operator()(AccRef acc, const Unit& u, int wr, int wc, int fr, int fq) const {
        const int row0 = u.pm * BM + wr * 64 + fr; const bool isg = u.pn >= 12;
        const float as = isg ? gsc : 1.0f;
        const float qs = (u.pn < 8) ? 0.08838834764831845f * LOG2E : 1.0f;
        const int col0 = (isg ? (u.pn - 12) : u.pn) * BM + wc * 32 + 8 * fq; bf16_t* base = isg ? gate : qkv; const int ldc = isg ? 4096 : 3072;
        f32x4 bv[2][2];
#pragma unroll
        for (int bj = 0; bj < 2; ++bj)
#pragma unroll
            for (int n = 0; n < 2; ++n) bv[bj][n] = isg ? *(const f32x4*)(bgate + col0 + bj * HALF + 4 * n) : (f32x4){0.f, 0.f, 0.f, 0.f};
#pragma unroll
        for (int ai = 0; ai < 2; ++ai)
#pragma unroll
            for (int m = 0; m < 4; ++m) { bf16_t* rowp = base + (size_t)(row0 + ai * HALF + m * 16) * ldc + col0;
#pragma unroll
                for (int bj = 0; bj < 2; ++bj) { f32x4 v0 = (acc[ai][bj][m][0] * as + bv[bj][0]) * qs, v1 = (acc[ai][bj][m][1] * as + bv[bj][1]) * qs;
                    if (isg) {
#pragma unroll
                        for (int j = 0; j < 4; ++j) { v0[j] = sigmoidf_(v0[j]); v1[j] = sigmoidf_(v1[j]); } }
                    *(u32x4*)(rowp + bj * HALF) = pack8(v0, v1); } }
    }
};
struct EpiGate8 {
    static constexpr bool PERM = true;
    bf16_t* gate; const float* bgate;
    __device__ __forceinline__ void operator()(AccRef acc, const Unit& u, int wr, int wc, int fr, int fq) const {
        const int row0 = u.pm * BM + wr * 64 + fr, col0 = u.pn * BM + wc * 32 + 8 * fq;
        f32x4 bv[2][2];
#pragma unroll
        for (int bj = 0; bj < 2; ++bj)
#pragma unroll
            for (int n = 0; n < 2; ++n) bv[bj][n] = *(const f32x4*)(bgate + col0 + bj * HALF + 4 * n);
#pragma unroll
        for (int ai = 0; ai < 2; ++ai)
#pragma unroll
            for (int m = 0; m < 4; ++m) { bf16_t* rowp = gate + (size_t)(row0 + ai * HALF + m * 16) * 4096 + col0;
#pragma unroll
                for (int bj = 0; bj < 2; ++bj) { f32x4 v0 = acc[ai][bj][m][0] * 0.00390625f + bv[bj][0], v1 = acc[ai][bj][m][1] * 0.00390625f + bv[bj][1];
#pragma unroll
                    for (int j = 0; j < 4; ++j) { v0[j] = sigmoidf_(v0[j]); v1[j] = sigmoidf_(v1[j]); }
                    *(u32x4*)(rowp + bj * HALF) = pack8(v0, v1); } }
    }
};
struct EpiBf16 {
    static constexpr bool PERM = true;
    bf16_t* out; int ld; int ut;
    __device__ __forceinline__ void operator()(AccRef acc, const Unit& u, int wr, int wc, int fr, int fq) const {
        size_t tb;
        if (ut == 1) { const int part = u.pm >> 2, cbase = (u.pm & 3) * 256, b = u.pn >> 3, sbase = (u.pn & 7) * 256; tb = ((size_t)(b * 1024 + cbase) * 2 + part) * 2048 + sbase; }
        else if (ut == 2) tb = (size_t)(u.pn >> 2) * ((size_t)NBATCH * 1024 * 1024) + (size_t)u.pm * BM * 1024 + (size_t)(u.pn & 3) * BM;
        else tb = (size_t)u.pm * BM * ld + (size_t)u.pn * BM;
        bf16_t* p0 = out + tb + (size_t)(wr * 64 + fr) * ld + wc * 32 + 8 * fq;
#pragma unroll
        for (int ai = 0; ai < 2; ++ai)
#pragma unroll
            for (int m = 0; m < 4; ++m) { bf16_t* rowp = p0 + (size_t)(ai * HALF + m * 16) * ld;
#pragma unroll
                for (int bj = 0; bj < 2; ++bj) *(u32x4*)(rowp + bj * HALF) = pack8(acc[ai][bj][m][0], acc[ai][bj][m][1]); }
    }
};
struct EpiRE {
    static constexpr bool PERM = true;
    bf16_t* out; const float* u1024;
    __device__ __forceinline__ void operator()(AccRef acc, const Unit& u, int wr, int wc, int fr, int fq) const {
        const int col0 = u.pn * BM + wc * 32 + 8 * fq; const float sg = (fr & 1) ? -1.0f : 1.0f;
        const float* up = u1024 + (size_t)(u.pm >> 3) * 1024 + col0;
        f32x4 uv[2][2];
#pragma unroll
        for (int bj = 0; bj < 2; ++bj)
#pragma unroll
            for (int n = 0; n < 2; ++n) uv[bj][n] = *(const f32x4*)(up + bj * HALF + 4 * n) * sg;
        bf16_t* p0 = out + ((size_t)u.pm * BM + wr * 64 + fr) * 1024 + col0;
#pragma unroll
        for (int ai = 0; ai < 2; ++ai)
#pragma unroll
            for (int m = 0; m < 4; ++m) { bf16_t* rowp = p0 + (size_t)(ai * HALF + m * 16) * 1024;
#pragma unroll
                for (int bj = 0; bj < 2; ++bj) *(u32x4*)(rowp + bj * HALF) = pack8(acc[ai][bj][m][0] + uv[bj][0], acc[ai][bj][m][1] + uv[bj][1]); }
    }
};
struct EpiREsym {
    static constexpr bool PERM = true;
    bf16_t* out; bf16_t* tmp2; const float* u1024;
    __device__ __forceinline__ void operator()(AccRef acc, const Unit& u, int wr, int wc, int fr, int fq) const {
        const int col0 = u.pn * BM + wc * 32 + 8 * fq, b = u.pm >> 2, t0 = (u.pm & 3) * BM + wr * 64 + fr;
        bf16_t* tp0 = tmp2 + ((size_t)u.pm * BM + wr * 64 + fr) * 1024 + col0;
        if (u.part == 0) {
#pragma unroll
            for (int ai = 0; ai < 2; ++ai)
#pragma unroll
                for (int m = 0; m < 4; ++m)
#pragma unroll
                    for (int bj = 0; bj < 2; ++bj) *(u32x4*)(tp0 + (size_t)(ai * HALF + m * 16) * 1024 + bj * HALF) = pack8(acc[ai][bj][m][0], acc[ai][bj][m][1]);
            return;
        }
        const float sg = (fr & 1) ? -1.0f : 1.0f; const float* up = u1024 + (size_t)b * 1024 + col0;
        f32x4 uv[2][2];
#pragma unroll
        for (int bj = 0; bj < 2; ++bj)
#pragma unroll
            for (int n = 0; n < 2; ++n) uv[bj][n] = *(const f32x4*)(up + bj * HALF + 4 * n) * sg;
#pragma unroll
        for (int ai = 0; ai < 2; ++ai)
#pragma unroll
            for (int m = 0; m < 4; ++m) { const int t = t0 + ai * HALF + m * 16;
                bf16_t* lo = out + ((size_t)b * SEQ + t) * 1024 + col0; bf16_t* hi = out + ((size_t)b * SEQ + (SEQ - t)) * 1024 + col0;
#pragma unroll
                for (int bj = 0; bj < 2; ++bj) { const u32x4 pw = *(const u32x4*)(tp0 + (size_t)(ai * HALF + m * 16) * 1024 + bj * HALF);
                    const f32x4 p0 = (f32x4){bf_lo(pw.x), bf_hi(pw.x), bf_lo(pw.y), bf_hi(pw.y)} + uv[bj][0], p1 = (f32x4){bf_lo(pw.z), bf_hi(pw.z), bf_lo(pw.w), bf_hi(pw.w)} + uv[bj][1];
                    *(u32x4*)(lo + bj * HALF) = pack8(p0 + acc[ai][bj][m][0], p1 + acc[ai][bj][m][1]);
                    if (t != 0) *(u32x4*)(hi + bj * HALF) = pack8(p0 - acc[ai][bj][m][0], p1 - acc[ai][bj][m][1]); } }
    }
};
template <int PART> struct EpiMerge {
    static constexpr bool PERM = true;
    const bf16_t* G; const bf16_t* tmp_in; bf16_t* out;
    __device__ __forceinline__ void operator()(AccRef acc, const Unit& u, int wr, int wc, int fr, int fq) const {
        const int row0 = u.pm * BM + wr * 64 + fr, col0 = u.pn * BM + wc * 32 + 8 * fq;
#pragma unroll
        for (int ai = 0; ai < 2; ++ai)
#pragma unroll
            for (int m = 0; m < 4; ++m) { const size_t row = (size_t)(row0 + ai * HALF + m * 16);
#pragma unroll
                for (int bj = 0; bj < 2; ++bj) { const int col = col0 + bj * HALF;
                    const u32x4 g = *(const u32x4*)(G + row * 4096 + PART * 2048 + col);
                    f32x4 v0 = acc[ai][bj][m][0], v1 = acc[ai][bj][m][1];
                    v0[0] *= bf_lo(g.x); v0[1] *= bf_hi(g.x); v0[2] *= bf_lo(g.y); v0[3] *= bf_hi(g.y); v1[0] *= bf_lo(g.z); v1[1] *= bf_hi(g.z); v1[2] *= bf_lo(g.w); v1[3] *= bf_hi(g.w);
                    if (PART == 1) { const u32x4 t = *(const u32x4*)(tmp_in + row * 2048 + col);
                        v0[0] += bf_lo(t.x); v0[1] += bf_hi(t.x); v0[2] += bf_lo(t.y); v0[3] += bf_hi(t.y); v1[0] += bf_lo(t.z); v1[1] += bf_hi(t.z); v1[2] += bf_lo(t.w); v1[3] += bf_hi(t.w); }
                    *(u32x4*)(out + row * 2048 + col) = pack8(v0, v1); } }
    }
};
struct EpiRes {
    static constexpr bool PERM = false;
    const float* base0; const float* base1; int split; const float* gate; float* out;
    __device__ __forceinline__ void operator()(AccRef acc, const Unit& u, int wr, int wc, int fr, int fq) const {
        const int rl0 = wr * 64 + fr, col0 = u.pn * BM + wc * 32 + 4 * fq;
        const float* bp = (u.pm < split) ? base0 + (size_t)u.pm * BM * DM : base1 + (size_t)(u.pm - split) * BM * DM;
        float* op = out + (size_t)u.pm * BM * DM; const float* gp = gate + (size_t)(u.pm >> 3) * NMOD + col0;
        f32x4 gv[2][2];
#pragma unroll
        for (int bj = 0; bj < 2; ++bj)
#pragma unroll
            for (int n = 0; n < 2; ++n) gv[bj][n] = *(const f32x4*)(gp + bj * HALF + n * 16);
#pragma unroll
        for (int aim = 0; aim < 4; ++aim) {
            const int ai = aim >> 1, mb = (aim & 1) * 2;
            f32x4 bs[2][2][2];
#pragma unroll
            for (int m = 0; m < 2; ++m) { const size_t off = (size_t)(rl0 + ai * HALF + (mb + m) * 16) * DM + col0;
#pragma unroll
                for (int bj = 0; bj < 2; ++bj)
#pragma unroll
                    for (int n = 0; n < 2; ++n) bs[m][bj][n] = *(const f32x4*)(bp + off + bj * HALF + n * 16); }
#pragma unroll
            for (int m = 0; m < 2; ++m) { const size_t off = (size_t)(rl0 + ai * HALF + (mb + m) * 16) * DM + col0;
#pragma unroll
                for (int bj = 0; bj < 2; ++bj)
#pragma unroll
                    for (int n = 0; n < 2; ++n) *(f32x4*)(op + off + bj * HALF + n * 16) = bs[m][bj][n] + gv[bj][n] * acc[ai][bj][mb + m][n]; }
            asm volatile("" ::: "memory"); }
    }
};
template <int MODE> struct EpiResT {
    static constexpr bool PERM = true;
    const float* base0; const float* base1; int split; const bf16_t* base16; const float* gate; float* out32; bf16_t* out16;
    __device__ __forceinline__ void operator()(AccRef acc, const Unit& u, int wr, int wc, int fr, int fq) const {
        const int rl0 = wr * 64 + fr, col0 = u.pn * BM + wc * 32 + 8 * fq;
        const float* gp = gate + (size_t)(u.pm >> 3) * NMOD + col0;
        f32x4 gv[2][2];
#pragma unroll
        for (int bj = 0; bj < 2; ++bj)
#pragma unroll
            for (int n = 0; n < 2; ++n) gv[bj][n] = *(const f32x4*)(gp + bj * HALF + 4 * n);
        if constexpr (MODE == 1) {
            const float* bp = (u.pm < split) ? base0 + (size_t)u.pm * BM * DM : base1 + (size_t)(u.pm - split) * BM * DM;
            bf16_t* op = out16 + (size_t)u.pm * BM * DM;
#pragma unroll
            for (int aim = 0; aim < 4; ++aim) {
                const int ai = aim >> 1, mb = (aim & 1) * 2;
                f32x4 bs[2][2][2];
#pragma unroll
                for (int m = 0; m < 2; ++m) { const size_t off = (size_t)(rl0 + ai * HALF + (mb + m) * 16) * DM + col0;
#pragma unroll
                    for (int bj = 0; bj < 2; ++bj)
#pragma unroll
                        for (int n = 0; n < 2; ++n) bs[m][bj][n] = *(const f32x4*)(bp + off + bj * HALF + 4 * n); }
#pragma unroll
                for (int m = 0; m < 2; ++m) { const size_t off = (size_t)(rl0 + ai * HALF + (mb + m) * 16) * DM + col0;
#pragma unroll
                    for (int bj = 0; bj < 2; ++bj) *(u32x4*)(op + off + bj * HALF) = pack8(bs[m][bj][0] + gv[bj][0] * acc[ai][bj][mb + m][0], bs[m][bj][1] + gv[bj][1] * acc[ai][bj][mb + m][1]); }
                asm volatile("" ::: "memory"); }
        } else {
            const bf16_t* bp = base16 + (size_t)u.pm * BM * DM; float* op = out32 + (size_t)u.pm * BM * DM;
#pragma unroll
            for (int ai = 0; ai < 2; ++ai) {
                u32x4 t[4][2];
#pragma unroll
                for (int m = 0; m < 4; ++m) { const size_t off = (size_t)(rl0 + ai * HALF + m * 16) * DM + col0;
#pragma unroll
                    for (int bj = 0; bj < 2; ++bj) t[m][bj] = *(const u32x4*)(bp + off + bj * HALF); }
#pragma unroll
                for (int m = 0; m < 4; ++m) { const size_t off = (size_t)(rl0 + ai * HALF + m * 16) * DM + col0;
#pragma unroll
                    for (int bj = 0; bj < 2; ++bj) { const u32x4 w = t[m][bj];
                        *(f32x4*)(op + off + bj * HALF) = (f32x4){bf_lo(w.x), bf_hi(w.x), bf_lo(w.y), bf_hi(w.y)} + gv[bj][0] * acc[ai][bj][m][0];
                        *(f32x4*)(op + off + bj * HALF + 4) = (f32x4){bf_lo(w.z), bf_hi(w.z), bf_lo(w.w), bf_hi(w.w)} + gv[bj][1] * acc[ai][bj][m][1]; } }
                asm volatile("" ::: "memory"); }
        }
    }
};
struct EpiSwiGLU {
    static constexpr bool PERM = false;
    bf16_t* act;
    __device__ __forceinline__ void operator()(AccRef acc, const Unit& u, int wr, int wc, int fr, int fq) const {
        bf16_t* p0 = act + (size_t)(u.pm * BM + wr * 64 + fr) * DFF + u.pn * 128 + wc * 32 + 8 * fq;
#pragma unroll
        for (int ai = 0; ai < 2; ++ai)
#pragma unroll
            for (int m = 0; m < 4; ++m) { f32x4 o[2];
#pragma unroll
                for (int bj = 0; bj < 2; ++bj)
#pragma unroll
                    for (int j = 0; j < 4; ++j) { const float g = acc[ai][bj][m][0][j]; o[bj][j] = g * sigmoidf_(g) * acc[ai][bj][m][1][j]; }
                *(u32x4*)(p0 + (size_t)(ai * HALF + m * 16) * DFF) = pack8(o[0], o[1]); }
    }
};
}

struct Args {
    const float *xp, *xs, *cp, *cs, *w_mod, *b_mod, *g_mix, *w_in, *sink, *w_attn, *w_four, *w_gate, *b_gate, *w_out, *g_ffn, *w_up, *w_down, *g_final;
    float* out; unsigned char* ws;
};

struct SrcIdent { __device__ __forceinline__ int operator()(int R) const { return R; } };
struct SrcUp { __device__ __forceinline__ int operator()(int R) const {
    const int pn = R >> 8, r = R & 255, bj = r >> 7, wc = (r >> 5) & 3, n = (r >> 4) & 1, i = r & 15, fq = i >> 2, j = i & 3;
    return (n ? DFF : 0) + 128 * pn + 32 * wc + 8 * fq + 4 * bj + j; } };
template <class Src> __device__ __forceinline__ void transpose_item(const float* W, int ldw, int K, bf16_t* WT, int nrows, int row_off, const Src src, LAS float* scr, int item, int lane) {
    const int nblk = nrows / 32, kb = item / nblk, nb = item % nblk, k0 = 64 * kb, n0 = 32 * nb;
    const int sc = src(n0 + (lane & 31));
#pragma unroll 8
    for (int i = 0; i < 32; ++i) { const int kk = 2 * i + (lane >> 5); scr[kk * 33 + (lane & 31)] = W[(size_t)(k0 + kk) * ldw + sc]; }
    asm volatile("s_waitcnt lgkmcnt(0)" ::: "memory");
    const int c = lane & 7;
#pragma unroll
    for (int j = 0; j < 4; ++j) { const int n = (lane >> 3) + 8 * j; const LAS float* s = scr + (8 * c) * 33 + n;
        u32x4 o; o.x = cvt_pk_bf16(s[0 * 33], s[1 * 33]); o.y = cvt_pk_bf16(s[2 * 33], s[3 * 33]); o.z = cvt_pk_bf16(s[4 * 33], s[5 * 33]); o.w = cvt_pk_bf16(s[6 * 33], s[7 * 33]);
        *(u32x4*)(WT + (size_t)(row_off + n0 + n) * K + k0 + 8 * c) = o; }
    asm volatile("s_waitcnt lgkmcnt(0)" ::: "memory");
}

__device__ __forceinline__ void transpose_item_fp8(const float* W, int ldw, int K, unsigned char* WT, int nrows, float scale, LAS float* scr, int item, int lane) {
    const int nblk = nrows / 32, kb = item / nblk, nb = item % nblk, k0 = 64 * kb, n0 = 32 * nb;
#pragma unroll 8
    for (int i = 0; i < 32; ++i) { const int kk = 2 * i + (lane >> 5); scr[kk * 33 + (lane & 31)] = W[(size_t)(k0 + kk) * ldw + n0 + (lane & 31)]; }
    asm volatile("s_waitcnt lgkmcnt(0)" ::: "memory");
    const int c = lane & 3;
#pragma unroll
    for (int q = 0; q < 2; ++q) { const int n = (lane >> 2) + 16 * q; const LAS float* s = scr + (16 * c) * 33 + n;
        u32x4 o; o.x = pk_fp8x4(s[0 * 33] * scale, s[1 * 33] * scale, s[2 * 33] * scale, s[3 * 33] * scale); o.y = pk_fp8x4(s[4 * 33] * scale, s[5 * 33] * scale, s[6 * 33] * scale, s[7 * 33] * scale);
        o.z = pk_fp8x4(s[8 * 33] * scale, s[9 * 33] * scale, s[10 * 33] * scale, s[11 * 33] * scale); o.w = pk_fp8x4(s[12 * 33] * scale, s[13 * 33] * scale, s[14 * 33] * scale, s[15 * 33] * scale);
        *(u32x4*)(WT + (size_t)(n0 + n) * K + k0 + 16 * c) = o; }
    asm volatile("s_waitcnt lgkmcnt(0)" ::: "memory");
}

template <bool OUT_BF16, bool HAS_MOD>
__device__ __forceinline__ void norm_rows(const float* src0, const float* src1, const float* g, const float* mod_shift, const float* mod_scale, void* outp, int gw, int NGW, int lane) {
    asm volatile("" : "+v"(lane));
    for (int m0 = gw; m0 < MTOK; m0 += 2 * NGW) {
        const int m1 = m0 + NGW; const bool has1 = m1 < MTOK; const int m1c = has1 ? m1 : m0;
        const float* xr0 = (m0 < NPR) ? src0 + (size_t)m0 * DM : src1 + (size_t)(m0 - NPR) * DM;
        const float* xr1 = (m1c < NPR) ? src0 + (size_t)m1c * DM : src1 + (size_t)(m1c - NPR) * DM;
        f32x4 v0[8], v1[8]; float s0 = 0.f, s1 = 0.f;
#pragma unroll
        for (int j = 0; j < 8; ++j) { v0[j] = __builtin_nontemporal_load((const f32x4*)xr0 + lane + 64 * j); v1[j] = __builtin_nontemporal_load((const f32x4*)xr1 + lane + 64 * j); }
#pragma unroll
        for (int j = 0; j < 8; ++j) { s0 += (v0[j].x * v0[j].x + v0[j].y * v0[j].y) + (v0[j].z * v0[j].z + v0[j].w * v0[j].w); s1 += (v1[j].x * v1[j].x + v1[j].y * v1[j].y) + (v1[j].z * v1[j].z + v1[j].w * v1[j].w); }
#pragma unroll
        for (int o = 1; o < 64; o <<= 1) { s0 += __shfl_xor(s0, o); s1 += __shfl_xor(s1, o); }
        const float r0 = 1.0f / sqrtf(s0 * (1.0f / DM) + RMS_EPS), r1 = 1.0f / sqrtf(s1 * (1.0f / DM) + RMS_EPS);
        const int b0 = m0 >> 11, b1 = m1c >> 11;
#pragma unroll
        for (int j = 0; j < 8; ++j) { const int col = 4 * lane + 256 * j; const f32x4 gg = *(const f32x4*)(g + col);
            f32x4 y0 = v0[j] * r0 * gg, y1 = v1[j] * r1 * gg;
            if (HAS_MOD) { const f32x4 sc0 = *(const f32x4*)(mod_scale + (size_t)b0 * NMOD + col), sh0 = *(const f32x4*)(mod_shift + (size_t)b0 * NMOD + col); y0 = y0 * (1.0f + sc0) + sh0;
                           const f32x4 sc1 = *(const f32x4*)(mod_scale + (size_t)b1 * NMOD + col), sh1 = *(const f32x4*)(mod_shift + (size_t)b1 * NMOD + col); y1 = y1 * (1.0f + sc1) + sh1; }
            if (OUT_BF16) { u32x2 w; w.x = cvt_pk_bf16(y0.x, y0.y); w.y = cvt_pk_bf16(y0.z, y0.w); *(u32x2*)((bf16_t*)outp + (size_t)m0 * DM + col) = w;
                            if (has1) { u32x2 w1; w1.x = cvt_pk_bf16(y1.x, y1.y); w1.y = cvt_pk_bf16(y1.z, y1.w); *(u32x2*)((bf16_t*)outp + (size_t)m1 * DM + col) = w1; } }
            else { __builtin_nontemporal_store(y0, (f32x4*)((float*)outp + (size_t)m0 * DM + col)); if (has1) __builtin_nontemporal_store(y1, (f32x4*)((float*)outp + (size_t)m1 * DM + col)); } }
    }
}


__device__ __forceinline__ void norm_pair_rows(const float* src0, const float* src1, const float* g, const float* mod_shift, const float* mod_scale, bf16_t* Hout, bf16_t* HF, unsigned char* H8, int gw, int NGW, int lane) {
    asm volatile("" : "+v"(lane));
    for (int it = gw; it < NBATCH * 1025; it += NGW) {
        const int b = it / 1025, s = it - b * 1025, p = (2048 - s) & 2047;
        const int m0 = b * SEQ + s, m1 = b * SEQ + p;
        const float* xr0 = (m0 < NPR) ? src0 + (size_t)m0 * DM : src1 + (size_t)(m0 - NPR) * DM;
        const float* xr1 = (m1 < NPR) ? src0 + (size_t)m1 * DM : src1 + (size_t)(m1 - NPR) * DM;
        f32x4 v0[8], v1[8]; float s0 = 0.f, s1 = 0.f;
#pragma unroll
        for (int j = 0; j < 8; ++j) { v0[j] = __builtin_nontemporal_load((const f32x4*)xr0 + lane + 64 * j); v1[j] = __builtin_nontemporal_load((const f32x4*)xr1 + lane + 64 * j); }
#pragma unroll
        for (int j = 0; j < 8; ++j) { s0 += (v0[j].x * v0[j].x + v0[j].y * v0[j].y) + (v0[j].z * v0[j].z + v0[j].w * v0[j].w); s1 += (v1[j].x * v1[j].x + v1[j].y * v1[j].y) + (v1[j].z * v1[j].z + v1[j].w * v1[j].w); }
#pragma unroll
        for (int o = 1; o < 64; o <<= 1) { s0 += __shfl_xor(s0, o); s1 += __shfl_xor(s1, o); }
        const float r0 = 1.0f / sqrtf(s0 * (1.0f / DM) + RMS_EPS), r1 = 1.0f / sqrtf(s1 * (1.0f / DM) + RMS_EPS);
        const bool pair = (p != s), fold = (s < 1024);
#pragma unroll
        for (int j = 0; j < 8; ++j) { const int col = 4 * lane + 256 * j; const f32x4 gg = *(const f32x4*)(g + col);
            const f32x4 sc = *(const f32x4*)(mod_scale + (size_t)b * NMOD + col), sh = *(const f32x4*)(mod_shift + (size_t)b * NMOD + col);
            const f32x4 y0 = v0[j] * r0 * gg * (1.0f + sc) + sh, y1 = v1[j] * r1 * gg * (1.0f + sc) + sh;
            u32x2 w; w.x = cvt_pk_bf16(y0.x, y0.y); w.y = cvt_pk_bf16(y0.z, y0.w); *(u32x2*)(Hout + (size_t)m0 * DM + col) = w;
            *(unsigned*)(H8 + (size_t)m0 * DM + col) = pk_fp8x4(y0.x * 4.0f, y0.y * 4.0f, y0.z * 4.0f, y0.w * 4.0f);
            if (pair) { u32x2 w1; w1.x = cvt_pk_bf16(y1.x, y1.y); w1.y = cvt_pk_bf16(y1.z, y1.w); *(u32x2*)(Hout + (size_t)m1 * DM + col) = w1;
                        *(unsigned*)(H8 + (size_t)m1 * DM + col) = pk_fp8x4(y1.x * 4.0f, y1.y * 4.0f, y1.z * 4.0f, y1.w * 4.0f); }
            if (fold) { const f32x4 pl = pair ? (y0 + y1) : y0, mi = y0 - y1;
                u32x2 wp, wm; wp.x = cvt_pk_bf16(pl.x, pl.y); wp.y = cvt_pk_bf16(pl.z, pl.w); wm.x = cvt_pk_bf16(mi.x, mi.y); wm.y = cvt_pk_bf16(mi.z, mi.w);
                *(u32x2*)(HF + ((size_t)b * SEQ + s) * DM + col) = wp; *(u32x2*)(HF + ((size_t)b * SEQ + 1024 + s) * DM + col) = wm; } }
    }
}


__device__ __forceinline__ void norm_rows_bf16src(const bf16_t* src, const float* g, const float* mod_shift, const float* mod_scale, bf16_t* outp, int gw, int NGW, int lane) {
    asm volatile("" : "+v"(lane));
    for (int m0 = gw; m0 < MTOK; m0 += 2 * NGW) {
        const int m1 = m0 + NGW; const bool has1 = m1 < MTOK; const int m1c = has1 ? m1 : m0;
        const u32x4* p0 = (const u32x4*)(src + (size_t)m0 * DM); const u32x4* p1 = (const u32x4*)(src + (size_t)m1c * DM);
        u32x4 w0[4], w1[4]; float s0 = 0.f, s1 = 0.f;
#pragma unroll
        for (int j = 0; j < 4; ++j) { w0[j] = __builtin_nontemporal_load(p0 + lane + 64 * j); w1[j] = __builtin_nontemporal_load(p1 + lane + 64 * j); }
#pragma unroll
        for (int j = 0; j < 4; ++j)
#pragma unroll
            for (int e = 0; e < 4; ++e) { const float a0 = bf_lo(w0[j][e]), b0 = bf_hi(w0[j][e]), a1 = bf_lo(w1[j][e]), b1 = bf_hi(w1[j][e]); s0 += a0 * a0 + b0 * b0; s1 += a1 * a1 + b1 * b1; }
#pragma unroll
        for (int o = 1; o < 64; o <<= 1) { s0 += __shfl_xor(s0, o); s1 += __shfl_xor(s1, o); }
        const float r0 = 1.0f / sqrtf(s0 * (1.0f / DM) + RMS_EPS), r1 = 1.0f / sqrtf(s1 * (1.0f / DM) + RMS_EPS);
        const int b0i = m0 >> 11, b1i = m1c >> 11;
#pragma unroll
        for (int j = 0; j < 4; ++j) { const int col = 8 * lane + 512 * j; f32x4 y0[2], y1[2];
#pragma unroll
            for (int hh = 0; hh < 2; ++hh) { const int c4 = col + 4 * hh; const f32x4 gg = *(const f32x4*)(g + c4);
                const f32x4 sc0 = *(const f32x4*)(mod_scale + (size_t)b0i * NMOD + c4), sh0 = *(const f32x4*)(mod_shift + (size_t)b0i * NMOD + c4);
                const f32x4 sc1 = *(const f32x4*)(mod_scale + (size_t)b1i * NMOD + c4), sh1 = *(const f32x4*)(mod_shift + (size_t)b1i * NMOD + c4);
                const f32x4 x0 = (f32x4){bf_lo(w0[j][2 * hh]), bf_hi(w0[j][2 * hh]), bf_lo(w0[j][2 * hh + 1]), bf_hi(w0[j][2 * hh + 1])};
                const f32x4 x1 = (f32x4){bf_lo(w1[j][2 * hh]), bf_hi(w1[j][2 * hh]), bf_lo(w1[j][2 * hh + 1]), bf_hi(w1[j][2 * hh + 1])};
                y0[hh] = x0 * r0 * gg * (1.0f + sc0) + sh0; y1[hh] = x1 * r1 * gg * (1.0f + sc1) + sh1; }
            *(u32x4*)(outp + (size_t)m0 * DM + col) = pg8::pack8(y0[0], y0[1]);
            if (has1) *(u32x4*)(outp + (size_t)m1 * DM + col) = pg8::pack8(y1[0], y1[1]); }
    }
}

__device__ __forceinline__ void attn_phase(LAS unsigned char* lds, const bf16_t* QKV, bf16_t* AO, const float* sink, int ubeg, int uend, int ustep) {
    int tid_ = threadIdx.x; asm volatile("" : "+v"(tid_));
    const int tid = tid_, lane = tid & 63, wid = __builtin_amdgcn_readfirstlane(tid >> 6);
    const int r = lane & 31, h = lane >> 5, hg = wid >> 1, w2 = wid & 1;
    constexpr int KPB = 272, VPB = 136, CHB = 17408;
    LAS unsigned char* Kb = lds; LAS unsigned char* Vb = lds + 2 * CHB; LAS unsigned char* Ow = lds + 4 * CHB + wid * (32 * KPB);
    int cc = 0;
    for (int u = ubeg; u < uend; u += ustep) {
        const int b = u >> 7, kvh = (u >> 5) & 3, qb = u & 31, a0 = qb * 64, q0 = a0 + 32 * w2, hq = kvh * 4 + hg;
        const float slope2 = exp2f(-0.5f * (float)(hq + 1)) * LOG2E, sink2 = sink[hq] * LOG2E;
        bf16x8 qf[8];
        { const bf16_t* qrow = QKV + (size_t)(b * SEQ + q0 + r) * 3072 + hq * 128 + 8 * h;
#pragma unroll
          for (int ks = 0; ks < 8; ++ks) qf[ks] = *(const bf16x8*)(qrow + 16 * ks); }
        f32x16 ot[4];
#pragma unroll
        for (int dt = 0; dt < 4; ++dt)
#pragma unroll
            for (int i = 0; i < 16; ++i) ot[dt][i] = 0.f;
        float m_run = sink2, l_run = 1.0f;
        const int jlo = (2 - qb) > 0 ? (2 - qb) : 0, jhi = (33 - qb) < 4 ? (33 - qb) : 4;
        u32x4 kreg[2][2], vreg[2][2];
        const int kp = tid & 31, dg = tid >> 5;
#define ATT_LOAD(S_, j) do { const size_t tokb = (size_t)(b * SEQ + a0 - 128 + 64 * (j)); \
            _Pragma("unroll") for (int i = 0; i < 2; ++i) { const int p = tid + 512 * i; kreg[S_][i] = *(const u32x4*)(QKV + (tokb + (p >> 4)) * 3072 + 2048 + kvh * 128 + (p & 15) * 8); } \
            _Pragma("unroll") for (int i = 0; i < 2; ++i) vreg[S_][i] = *(const u32x4*)(QKV + (tokb + 2 * kp + i) * 3072 + 2560 + kvh * 128 + dg * 8); } while (0)
        ATT_LOAD(0, jlo); if (jlo + 1 <= jhi) ATT_LOAD(1, jlo + 1);
        for (int j = jlo; j <= jhi; j += 2) {
#pragma unroll
          for (int sub = 0; sub < 2; ++sub) {
            const int jj = j + sub; if (jj > jhi) break;
            LAS unsigned char* Kc = Kb + (cc & 1) * CHB; LAS unsigned char* Vc = Vb + (cc & 1) * CHB; ++cc;
#pragma unroll
            for (int i = 0; i < 2; ++i) { const int p = tid + 512 * i; *(LAS u32x4*)(Kc + (p >> 4) * KPB + (p & 15) * 16) = kreg[sub][i]; }
#pragma unroll
            for (int w = 0; w < 4; ++w) { const unsigned x0 = vreg[sub][0][w], x1 = vreg[sub][1][w];
                *(LAS unsigned*)(Vc + (8 * dg + 2 * w) * VPB + kp * 4) = (x0 & 0xffffu) | (x1 << 16);
                *(LAS unsigned*)(Vc + (8 * dg + 2 * w + 1) * VPB + kp * 4) = (x0 >> 16) | (x1 & 0xffff0000u); }
            __syncthreads();
            if (jj + 2 <= jhi) { if (sub == 0) ATT_LOAD(0, jj + 2); else ATT_LOAD(1, jj + 2); }
            f32x16 st[2];
#pragma unroll
            for (int kt = 0; kt < 2; ++kt) {
#pragma unroll
                for (int i = 0; i < 16; ++i) st[kt][i] = 0.f;
#pragma unroll
                for (int ks = 0; ks < 8; ++ks) { const bf16x8 a = *(const LAS bf16x8*)(Kc + (32 * kt + r) * KPB + (16 * ks + 8 * h) * 2); st[kt] = __builtin_amdgcn_mfma_f32_32x32x16_bf16(a, qf[ks], st[kt], 0, 0, 0); } }
            const float frelb = (float)((a0 - 128 + 64 * jj + 4 * h) - (q0 + r));
            float mx = -INFINITY;
            if (jj == 0 || jj == 4) {
#pragma unroll
                for (int kt = 0; kt < 2; ++kt)
#pragma unroll
                    for (int i = 0; i < 16; ++i) { const float fr_ = frelb + (float)(32 * kt + (i & 3) + 8 * (i >> 2));
                        float t = fmaf(-slope2, fabsf(fr_), st[kt][i]); t = (fabsf(fr_) <= 128.0f) ? t : -INFINITY; st[kt][i] = t; mx = fmaxf(mx, t); }
            } else {
#pragma unroll
                for (int kt = 0; kt < 2; ++kt)
#pragma unroll
                    for (int i = 0; i < 16; ++i) { const float fr_ = frelb + (float)(32 * kt + (i & 3) + 8 * (i >> 2));
                        const float t = fmaf(-slope2, fabsf(fr_), st[kt][i]); st[kt][i] = t; mx = fmaxf(mx, t); }
            }
            mx = fmaxf(mx, __shfl_xor(mx, 32));
            const float m_new = fmaxf(m_run, mx), alpha = __builtin_amdgcn_exp2f(m_run - m_new); m_run = m_new;
            float ls = 0.f;
#pragma unroll
            for (int kt = 0; kt < 2; ++kt)
#pragma unroll
                for (int i = 0; i < 16; ++i) { const float p = __builtin_amdgcn_exp2f(st[kt][i] - m_new); st[kt][i] = p; ls += p; }
            ls += __shfl_xor(ls, 32); l_run = l_run * alpha + ls;
            if (__ballot(alpha != 1.0f) != 0ull) {
#pragma unroll
                for (int dt = 0; dt < 4; ++dt)
#pragma unroll
                    for (int i = 0; i < 16; ++i) ot[dt][i] *= alpha; }
#pragma unroll
            for (int kt = 0; kt < 2; ++kt)
#pragma unroll
                for (int s = 0; s < 2; ++s) {
                    u32x4 pw; pw.x = cvt_pk_bf16(st[kt][8 * s + 0], st[kt][8 * s + 1]); pw.y = cvt_pk_bf16(st[kt][8 * s + 2], st[kt][8 * s + 3]); pw.z = cvt_pk_bf16(st[kt][8 * s + 4], st[kt][8 * s + 5]); pw.w = cvt_pk_bf16(st[kt][8 * s + 6], st[kt][8 * s + 7]);
                    asm volatile("s_nop 1" ::: "memory");
                    const bf16x8 pf = __builtin_bit_cast(bf16x8, pw);
#pragma unroll
                    for (int dt = 0; dt < 4; ++dt) { const LAS unsigned char* vp = Vc + (32 * dt + r) * VPB + (32 * kt + 16 * s + 4 * h) * 2;
                        const s16x4 lo = *(const LAS s16x4*)vp, hi = *(const LAS s16x4*)(vp + 16);
                        const bf16x8 a2 = __builtin_shufflevector(lo, hi, 0, 1, 2, 3, 4, 5, 6, 7);
                        ot[dt] = __builtin_amdgcn_mfma_f32_32x32x16_bf16(a2, pf, ot[dt], 0, 0, 0); } }
          }
        }
#undef ATT_LOAD
        const float inv = 1.0f / l_run;
#pragma unroll
        for (int dt = 0; dt < 4; ++dt)
#pragma unroll
            for (int g4 = 0; g4 < 4; ++g4) { u32x2 w; w.x = cvt_pk_bf16(ot[dt][4 * g4] * inv, ot[dt][4 * g4 + 1] * inv); w.y = cvt_pk_bf16(ot[dt][4 * g4 + 2] * inv, ot[dt][4 * g4 + 3] * inv);
                *(LAS u32x2*)(Ow + r * KPB + (32 * dt + 8 * g4 + 4 * h) * 2) = w; }
        asm volatile("s_waitcnt lgkmcnt(0)" ::: "memory");
#pragma unroll
        for (int it = 0; it < 8; ++it) { const int row = it * 4 + (lane >> 4), c16 = lane & 15;
            const u32x4 v = *(const LAS u32x4*)(Ow + row * KPB + c16 * 16);
            *(u32x4*)(AO + (size_t)(b * SEQ + q0 + row) * DM + hq * 128 + c16 * 8) = v; }
        asm volatile("s_waitcnt lgkmcnt(0)" ::: "memory");
    }
    __syncthreads();
}

__global__ void __launch_bounds__(512, 2) fwd(Args a) {
    extern __shared__ __attribute__((aligned(16))) unsigned char lds_raw[];
    LAS unsigned char* lds = (LAS unsigned char*)lds_raw;
    cg::grid_group grid = cg::this_grid();
    const int tid = threadIdx.x, lane = tid & 63, wid = __builtin_amdgcn_readfirstlane(tid >> 6);
    const int G = gridDim.x, bx = blockIdx.x;
    const int gw = bx * NWAVES + wid, NGW = G * NWAVES;
    unsigned char* ws = a.ws;
    volatile LAS unsigned long long* pstamp = (volatile LAS unsigned long long*)(lds + 147392);
    if (PROBE >= 0 && bx == 0 && tid == 0) pstamp[1] = 0ull;
    volatile LAS unsigned* bst = (volatile LAS unsigned*)(lds + 147424);
    if (tid < 2) bst[tid] = 0u;
    __syncthreads();
    const XcdBarrier gbar = xcd_barrier_post((unsigned*)(ws + WS_BAR), bst);
#define GRID_BAR() xcd_barrier(gbar)
    float* mod = (float*)(ws + WS_MOD);
    bf16_t* WinT = (bf16_t*)(ws + WS_WIN); bf16_t* WuT = (bf16_t*)(ws + WS_WU); bf16_t* WaT = (bf16_t*)(ws + WS_WA); bf16_t* WfT = (bf16_t*)(ws + WS_WF);
    bf16_t* WoT = (bf16_t*)(ws + WS_WO); bf16_t* WupT = (bf16_t*)(ws + WS_WUP); bf16_t* WdT = (bf16_t*)(ws + WS_WD); bf16_t* Ft = (bf16_t*)(ws + WS_FT);
    bf16_t* Hb = (bf16_t*)(ws + WS_H); bf16_t* QKV = (bf16_t*)(ws + WS_QKV); bf16_t* UT = (bf16_t*)(ws + WS_UT); bf16_t* AO = (bf16_t*)(ws + WS_AO); bf16_t* RE = (bf16_t*)(ws + WS_RE);
    bf16_t* TMP = (bf16_t*)(ws + WS_TMP); bf16_t* MERGED = (bf16_t*)(ws + WS_MERGED); bf16_t* ACT = (bf16_t*)(ws + WS_ACT);
    unsigned char* H8 = ws + WS_H8; unsigned char* Wg8 = ws + WS_WG8;
    bf16_t* HF = (bf16_t*)(ws + WS_HF); bf16_t* Vf = (bf16_t*)(ws + WS_V); float* U1024 = (float*)(ws + WS_U1024);
    bf16_t* X1B = (bf16_t*)(ws + WS_X1B);
    bf16_t* Gt = (bf16_t*)a.out;

    PH_BEGIN(0);
    {
        LAS f32x2* tab = (LAS f32x2*)(lds + 131072);
        if (tid < 256) { float s, c; sincospif((float)tid * (1.0f / 128.0f), &s, &c); tab[tid] = (f32x2){c * 0.0625f, s * 0.0625f}; }
        __syncthreads();
        for (int jb = bx; jb < NMOD / 64; jb += G) {
            const int col = jb * 64 + lane;
            LAS float* sl = (LAS float*)(lds + wid * 16384);
            float acc[NBATCH];
#pragma unroll
            for (int b = 0; b < NBATCH; ++b) acc[b] = 0.f;
            for (int half = 0; half < 2; ++half) {
                const int k0 = wid * 256 + half * 128;
                for (int i = 0; i < 40; ++i) { const int e = lane + 64 * i, kk = e & 127, bb = e >> 7;
                    const float c = (bb < 4) ? a.cp[bb * DM + k0 + kk] : a.cs[(bb - 4) * DM + k0 + kk];
                    sl[kk * NBATCH + bb] = c / (1.0f + expf(-c)); }
                asm volatile("s_waitcnt lgkmcnt(0)" ::: "memory");
#pragma unroll 8
                for (int kk = 0; kk < 128; ++kk) { const float w = a.w_mod[(size_t)(k0 + kk) * NMOD + col];
#pragma unroll
                    for (int q = 0; q < 5; ++q) { const f32x4 s = *(const LAS f32x4*)(sl + kk * NBATCH + 4 * q);
                        acc[4 * q] += s.x * w; acc[4 * q + 1] += s.y * w; acc[4 * q + 2] += s.z * w; acc[4 * q + 3] += s.w * w; } }
                asm volatile("s_waitcnt lgkmcnt(0)" ::: "memory");
            }
            LAS float* red = (LAS float*)(lds + wid * 16384 + 10240);
#pragma unroll
            for (int b = 0; b < NBATCH; ++b) red[b * 64 + lane] = acc[b];
            __syncthreads();
            for (int e = tid; e < NBATCH * 64; e += 512) { const int b = e >> 6, l = e & 63; float s = a.b_mod[jb * 64 + l];
#pragma unroll
                for (int w = 0; w < 8; ++w) s += ((const LAS float*)(lds + w * 16384 + 10240))[b * 64 + l];
                mod[(size_t)b * NMOD + jb * 64 + l] = s; }
            __syncthreads();
        }
        if (wid < 4) {
            for (int f = bx * 4 + wid; f < 1024; f += G * 4) {
                const int g = f >> 8, k0 = (f & 255) * 8;
                LAS float* wl = (LAS float*)(lds + wid * 16384);
#pragma unroll
                for (int i = 0; i < 8; ++i) { const f32x4 v = *(const f32x4*)(a.w_in + (size_t)(k0 + i) * 4096 + 3072 + g * 256 + 4 * lane);
                    wl[(4 * lane + 0) * 8 + i] = v.x; wl[(4 * lane + 1) * 8 + i] = v.y; wl[(4 * lane + 2) * 8 + i] = v.z; wl[(4 * lane + 3) * 8 + i] = v.w; }
                asm volatile("s_waitcnt lgkmcnt(0)" ::: "memory");
                float ac[4][8], as[4][8];
#pragma unroll
                for (int q = 0; q < 4; ++q)
#pragma unroll
                    for (int i = 0; i < 8; ++i) { ac[q][i] = 0.f; as[q][i] = 0.f; }
                int idx0 = 0, idx1 = 0, idx2 = 0, idx3 = 0;
                for (int d = 0; d < 256; ++d) {
                    const f32x4 w0 = *(const LAS f32x4*)(wl + d * 8), w1 = *(const LAS f32x4*)(wl + d * 8 + 4);
                    const float wv[8] = {w0.x, w0.y, w0.z, w0.w, w1.x, w1.y, w1.z, w1.w};
                    const f32x2 t0 = tab[idx0], t1 = tab[idx1], t2 = tab[idx2], t3 = tab[idx3];
                    idx0 = (idx0 + lane) & 255; idx1 = (idx1 + lane + 64) & 255; idx2 = (idx2 + lane + 128) & 255; idx3 = (idx3 + lane + 192) & 255;
#pragma unroll
                    for (int i = 0; i < 8; ++i) { ac[0][i] += wv[i] * t0.x; as[0][i] += wv[i] * t0.y; ac[1][i] += wv[i] * t1.x; as[1][i] += wv[i] * t1.y;
                        ac[2][i] += wv[i] * t2.x; as[2][i] += wv[i] * t2.y; ac[3][i] += wv[i] * t3.x; as[3][i] += wv[i] * t3.y; }
                }
#pragma unroll
                for (int q = 0; q < 4; ++q) { const int cp_ = lane + 64 * q;
                    u32x4 oc, os; oc.x = cvt_pk_bf16(ac[q][0], ac[q][1]); oc.y = cvt_pk_bf16(ac[q][2], ac[q][3]); oc.z = cvt_pk_bf16(ac[q][4], ac[q][5]); oc.w = cvt_pk_bf16(ac[q][6], ac[q][7]);
                    os.x = cvt_pk_bf16(as[q][0], as[q][1]); os.y = cvt_pk_bf16(as[q][2], as[q][3]); os.z = cvt_pk_bf16(as[q][4], as[q][5]); os.w = cvt_pk_bf16(as[q][6], as[q][7]);
                    *(u32x4*)(WuT + (size_t)(g * 256 + cp_) * DM + k0) = oc; *(u32x4*)(WuT + (size_t)(1024 + g * 256 + cp_) * DM + k0) = os; }
                asm volatile("s_waitcnt lgkmcnt(0)" ::: "memory");
            }
        }
        {
            constexpr int I1 = 32 * 96, I2 = 32 * 128, I3 = 32 * 64, I4 = 16 * 64, I5 = 32 * 64, I6 = 32 * 352, I7 = 88 * 64, I8 = 512;
            constexpr int NITEMS = I1 + I2 + I3 + I4 + I5 + I6 + I7 + I8;
            const int shard = bx & 7; unsigned* ctr = (unsigned*)(ws + WS_CTL) + 64 * shard;
            LAS float* scr = (LAS float*)(lds + wid * 16384);
            for (;;) {
                int it = 0; if (lane == 0) it = (int)atomicAdd(ctr, 1u);
                it = __builtin_amdgcn_readfirstlane(it) * 8 + shard;
                if (it >= NITEMS) break;
                int rr = it;
                if (rr < I1) { transpose_item(a.w_in, 4096, DM, WinT, 3072, 0, SrcIdent{}, scr, rr, lane); continue; } rr -= I1;
                if (rr < I2) { transpose_item_fp8(a.w_gate, 4096, DM, Wg8, 4096, 64.0f, scr, rr, lane); continue; } rr -= I2;
                if (rr < I3) { transpose_item(a.w_attn, DM, DM, WaT, DM, 0, SrcIdent{}, scr, rr, lane); continue; } rr -= I3;
                if (rr < I4) { transpose_item(a.w_four, DM, 1024, WfT, DM, 0, SrcIdent{}, scr, rr, lane); continue; } rr -= I4;
                if (rr < I5) { transpose_item(a.w_out, DM, DM, WoT, DM, 0, SrcIdent{}, scr, rr, lane); continue; } rr -= I5;
                if (rr < I6) { transpose_item(a.w_up, 2 * DFF, DM, WupT, 2 * DFF, 0, SrcUp{}, scr, rr, lane); continue; } rr -= I6;
                if (rr < I7) { transpose_item(a.w_down, DM, DFF, WdT, DM, 0, SrcIdent{}, scr, rr, lane); continue; } rr -= I7;
#pragma unroll 1
                for (int i = 0; i < 8; ++i) { const int piece = rr * 512 + lane + 64 * i, e0 = piece * 8, row = e0 >> 10, k = e0 & 1023, part = row >> 10, t = row & 1023;
                    float v[8];
#pragma unroll
                    for (int jj = 0; jj < 8; ++jj) { const int s_ = k + jj, idx = (t * s_) & 2047; float sn, cs; sincospif((float)idx * (1.0f / 1024.0f), &sn, &cs); v[jj] = (part ? -sn : cs) * 0.022097086912079608f; }
                    u32x4 o; o.x = cvt_pk_bf16(v[0], v[1]); o.y = cvt_pk_bf16(v[2], v[3]); o.z = cvt_pk_bf16(v[4], v[5]); o.w = cvt_pk_bf16(v[6], v[7]);
                    *(u32x4*)(Ft + (size_t)e0) = o; }
            }
        }
    }
    if (gridDim.y == 0x7fffu) grid.sync();
    GRID_BAR();
    PH_END(0);

    PH_BEGIN(1);
    norm_pair_rows(a.xp, a.xs, a.g_mix, mod + 0 * DM, mod + 1 * DM, Hb, HF, H8, gw, NGW, lane);
    GRID_BAR();
    PH_END(1);

    PH_BEGIN(2);
    { pg8::Order S; S.init(MTOK / 256, 12, G, bx, 0); pg8::EpiQKVG E{QKV, Gt, a.b_gate, 1.0f};
      pg8::gemm_phase<pg8::EpiQKVG, true, true>(lds, Hb, WinT, DM, S, E); }
    { pg8::Order S; S.init(MTOK / 256, 16, G, bx, 5); pg8::EpiQKVG E{QKV, Gt, a.b_gate, 0.00390625f};
      pg8::gemm_phase<pg8::EpiQKVG, false, true, true>(lds, (const bf16_t*)H8, (const bf16_t*)(Wg8 - (size_t)12 * 256 * DM), DM / 2, S, E); }
    PH_END(2); PH_BEGIN(3);
    { int lane = threadIdx.x & 63; asm volatile("" : "+v"(lane));
    for (int d = gw; d < NBATCH * 1024; d += NGW) { const int b = d >> 10, c = d & 1023;
        const u32x4* wr_ = (const u32x4*)(WuT + (size_t)c * DM); const u32x4* hr_ = (const u32x4*)(Hb + ((size_t)b * SEQ + 1024) * DM); float s = 0.f;
#pragma unroll
        for (int i = 0; i < 4; ++i) { const u32x4 w = wr_[lane + 64 * i], hv = hr_[lane + 64 * i];
            s += bf_lo(w.x) * bf_lo(hv.x) + bf_hi(w.x) * bf_hi(hv.x) + bf_lo(w.y) * bf_lo(hv.y) + bf_hi(w.y) * bf_hi(hv.y) + bf_lo(w.z) * bf_lo(hv.z) + bf_hi(w.z) * bf_hi(hv.z) + bf_lo(w.w) * bf_lo(hv.w) + bf_hi(w.w) * bf_hi(hv.w); }
        s = wave_sum(s); if (lane == 0) U1024[d] = s * 0.022097086912079608f; } }
    { pg8::Order S; S.init(NBATCH * 32, 1, G, (bx + G / 2) % G, 2); pg8::EpiBf16 E{Vf, 1024, 2};
      pg8::gemm_phase<pg8::EpiBf16, true, true>(lds, WuT, HF, DM, S, E); }
    GRID_BAR();
    PH_END(3);

    PH_BEGIN(4);
    {
        int ub = bx, ue = NBATCH * 4 * 32, us = G;
        if (G == 256) { if (bx < 64) { ub = bx * 7; ue = ub + 7; } else { ub = 448 + (bx - 64) * 11; ue = ub + 11; } us = 1; }
        attn_phase(lds, QKV, AO, a.sink, ub, ue, us);
    }
    PH_END(4); PH_BEGIN(5);
    { int lane = threadIdx.x & 63; asm volatile("" : "+v"(lane));
    for (int d = gw; d < NBATCH * 1024; d += NGW) { const u32x4* vr = (const u32x4*)(Vf + (size_t)d * 1024); float s = 0.f;
#pragma unroll
        for (int i = 0; i < 2; ++i) { const u32x4 w = vr[lane + 64 * i]; s += (bf_lo(w.x) - bf_hi(w.x)) + (bf_lo(w.y) - bf_hi(w.y)) + (bf_lo(w.z) - bf_hi(w.z)) + (bf_lo(w.w) - bf_hi(w.w)); }
        s = wave_sum(s); if (lane == 0) { const float v = s * 0.022097086912079608f + U1024[d]; RE[((size_t)(d >> 10) * SEQ + 1024) * 1024 + (d & 1023)] = (bf16_t)(cvt_pk_bf16(v, 0.f) & 0xffffu); } } }
    { pg8::Order S; S.init(NBATCH * 16, 1, G, bx, 4); pg8::EpiREsym E{RE, TMP, U1024};
      pg8::gemm_phase<pg8::EpiREsym, true, true>(lds, Ft, Vf, 1024, S, E); }
    GRID_BAR();
    PH_END(5);

    PH_BEGIN(6);
    { pg8::Order S; S.init(MTOK / 256, 8, G, bx, 0); pg8::EpiMerge<0> E{Gt, nullptr, TMP};
      pg8::gemm_phase<pg8::EpiMerge<0>, true, true>(lds, AO, WaT, DM, S, E); }
    { pg8::Order S; S.init(MTOK / 256, 8, G, bx, 0); pg8::EpiMerge<1> E{Gt, TMP, MERGED};
      pg8::gemm_phase<pg8::EpiMerge<1>, true, true>(lds, RE, WfT, 1024, S, E); }
    GRID_BAR();
    PH_END(6);

    PH_BEGIN(7);
    { pg8::Order S; S.init(MTOK / 256, 8, G, bx, 0); pg8::EpiResT<1> E{a.xp, a.xs, NPR / 256, nullptr, mod + 2 * DM, nullptr, X1B};
      pg8::gemm_phase<pg8::EpiResT<1>, true, true>(lds, MERGED, WoT, DM, S, E); }
    GRID_BAR();
    PH_END(7);

    PH_BEGIN(8);
    norm_rows_bf16src(X1B, a.g_ffn, mod + 3 * DM, mod + 4 * DM, Hb, gw, NGW, lane);
    GRID_BAR();
    PH_END(8);

    PH_BEGIN(9);
    { pg8::Order S; S.init(MTOK / 256, 44, G, bx, 0); pg8::EpiSwiGLU E{ACT};
      pg8::gemm_phase<pg8::EpiSwiGLU, true, true>(lds, Hb, WupT, DM, S, E); }
    GRID_BAR();
    PH_END(9);

    PH_BEGIN(10);
    { pg8::Order S; S.init(MTOK / 256, 8, G, bx, 0); pg8::EpiResT<2> E{nullptr, nullptr, 0, X1B, mod + 5 * DM, a.out, nullptr};
      pg8::gemm_phase<pg8::EpiResT<2>, true, true>(lds, ACT, WdT, DFF, S, E); }
    GRID_BAR();
    PH_END(10);

    PH_BEGIN(11);
    norm_rows<false, false>(a.out, a.out + (size_t)NPR * DM, a.g_final, nullptr, nullptr, a.out, gw, NGW, lane);
    PH_END(11);
    PH_BEGIN(12);
    if (PROBE >= 0 && ((PROBE >> 12) & 1)) { for (int i = 0; i < 5; ++i) GRID_BAR(); }
    PH_END(12);
    if (PROBE >= 0 && bx == 0 && tid == 0) { const unsigned long long d = pstamp[1], t2 = __builtin_amdgcn_s_memrealtime(); while (__builtin_amdgcn_s_memrealtime() - t2 < d) __builtin_amdgcn_s_sleep(8); }
}

extern "C" void kernel_launch(void* const* d_in, const int* in_sizes, int n_in, void* d_out, int out_size, void* d_ws, size_t ws_size, hipStream_t stream) {
    static int grid = 0;
    if (grid == 0) {
        if (n_in != 18 || out_size != MTOK * DM || ws_size < WS_END) { fprintf(stderr, "kernel_launch: unexpected problem (n_in %d, out %d, ws %zu < %zu)\n", n_in, out_size, ws_size, (size_t)WS_END); grid = -1; return; }
        int dev = 0, cus = 0, per_cu = 0;
        (void)hipGetDevice(&dev); (void)hipDeviceGetAttribute(&cus, hipDeviceAttributeMultiprocessorCount, dev);
        if (hipFuncSetAttribute((const void*)fwd, hipFuncAttributeMaxDynamicSharedMemorySize, LDS_BYTES) != hipSuccess) { fprintf(stderr, "kernel_launch: hipFuncSetAttribute failed\n"); grid = -1; return; }
        if (hipOccupancyMaxActiveBlocksPerMultiprocessor(&per_cu, (const void*)fwd, NWAVES * 64, LDS_BYTES) != hipSuccess || per_cu < 1) { fprintf(stderr, "kernel_launch: occupancy query says %d blocks/CU\n", per_cu); per_cu = 1; }
        (void)hipGetLastError();
        grid = cus * per_cu;
    }
    if (grid < 0) return;
    (void)hipMemsetAsync((char*)d_ws + WS_CTL, 0, CTL_BYTES, stream);
    Args a{};
    a.xp = (const float*)d_in[0]; a.xs = (const float*)d_in[1]; a.cp = (const float*)d_in[2]; a.cs = (const float*)d_in[3]; a.w_mod = (const float*)d_in[4]; a.b_mod = (const float*)d_in[5];
    a.g_mix = (const float*)d_in[6]; a.w_in = (const float*)d_in[7]; a.sink = (const float*)d_in[8]; a.w_attn = (const float*)d_in[9]; a.w_four = (const float*)d_in[10]; a.w_gate = (const float*)d_in[11];
    a.b_gate = (const float*)d_in[12]; a.w_out = (const float*)d_in[13]; a.g_ffn = (const float*)d_in[14]; a.w_up = (const float*)d_in[15]; a.w_down = (const float*)d_in[16]; a.g_final = (const float*)d_in[17];
    a.out = (float*)d_out; a.ws = (unsigned char*)d_ws;
    void* args[] = {&a};
    const hipError_t e = hipLaunchCooperativeKernel((void*)fwd, dim3(grid), dim3(NWAVES * 64), args, LDS_BYTES, stream);
    if (e != hipSuccess) fprintf(stderr, "kernel_launch: cooperative launch failed: %s (grid %d)\n", hipGetErrorString(e), grid);
}
```

```cpp
#include <hip/hip_runtime.h>
#include <hip/hip_cooperative_groups.h>
#include <cstdio>
#include <cstdint>
namespace cg = cooperative_groups;

#define LAS __attribute__((address_space(3)))
typedef unsigned short bf16_t;
typedef short bf16x8 __attribute__((ext_vector_type(8)));
typedef short s16x4 __attribute__((ext_vector_type(4)));
typedef float f32x4 __attribute__((ext_vector_type(4)));
typedef float f32x2 __attribute__((ext_vector_type(2)));
typedef float f32x16 __attribute__((ext_vector_type(16)));
typedef unsigned u32x4 __attribute__((ext_vector_type(4)));
typedef unsigned u32x2 __attribute__((ext_vector_type(2)));
typedef int i32x4 __attribute__((ext_vector_type(4)));
typedef int i32x8 __attribute__((ext_vector_type(8)));

constexpr int DM = 2048, SEQ = 2048, NBATCH = 20, MTOK = NBATCH * SEQ, NPR = 4 * SEQ;
constexpr int DFF = 5632, NMOD = 6 * DM;
constexpr float RMS_EPS = 1e-6f;
constexpr float LOG2E = 1.4426950408889634f;
constexpr size_t MiB = 1u << 20;
constexpr size_t WS_CTL = 0, WS_BAR = 4096, CTL_BYTES = 32768, WS_MOD = 32768;
constexpr size_t WS_WIN = 1 * MiB, WS_WU = 29 * MiB, WS_WA = 37 * MiB, WS_WF = 45 * MiB, WS_WO = 49 * MiB, WS_WUP = 57 * MiB, WS_WD = 101 * MiB, WS_FT = 123 * MiB;
constexpr size_t WS_H = 140 * MiB, WS_QKV = 300 * MiB, WS_UT = 540 * MiB, WS_AO = 700 * MiB, WS_RE = 860 * MiB, WS_U1024 = 940 * MiB, WS_END = 941 * MiB;
constexpr size_t WS_X1B = 740 * MiB;
constexpr size_t WS_H8 = 620 * MiB;
constexpr size_t WS_WG8 = WS_WIN + 12 * MiB;
constexpr size_t WS_HF = WS_AO, WS_V = WS_UT;
constexpr size_t WS_TMP = WS_H, WS_MERGED = WS_QKV, WS_ACT = WS_QKV;
constexpr int LDS_BYTES = 147456;
constexpr int NWAVES = 8;
#ifndef PROBE
#define PROBE -1
#endif
#define PH_BEGIN(k) do { if (PROBE >= 0 && ((PROBE >> (k)) & 1) && bx == 0 && tid == 0) pstamp[0] = __builtin_amdgcn_s_memrealtime(); } while (0)
#define PH_END(k)   do { if (PROBE >= 0 && ((PROBE >> (k)) & 1) && bx == 0 && tid == 0) pstamp[1] += __builtin_amdgcn_s_memrealtime() - pstamp[0]; } while (0)

__device__ __forceinline__ unsigned cvt_pk_bf16(float lo, float hi) { unsigned r; asm volatile("v_cvt_pk_bf16_f32 %0, %1, %2" : "=v"(r) : "v"(lo), "v"(hi)); return r; }
__device__ __forceinline__ unsigned pk_fp8x4(float a, float b, float c, float d) {
    a = fminf(fmaxf(a, -448.f), 448.f); b = fminf(fmaxf(b, -448.f), 448.f); c = fminf(fmaxf(c, -448.f), 448.f); d = fminf(fmaxf(d, -448.f), 448.f);
    int w = 0; w = __builtin_amdgcn_cvt_pk_fp8_f32(a, b, w, false); w = __builtin_amdgcn_cvt_pk_fp8_f32(c, d, w, true); return (unsigned)w; }
__device__ __forceinline__ float bf_lo(unsigned w) { return __uint_as_float(w << 16); }
__device__ __forceinline__ float bf_hi(unsigned w) { return __uint_as_float(w & 0xffff0000u); }
__device__ __forceinline__ float sigmoidf_(float v) { return __builtin_amdgcn_rcpf(1.0f + __builtin_amdgcn_exp2f(-v * LOG2E)); }
__device__ __forceinline__ float wave_sum(float v) {
#pragma unroll
    for (int o = 1; o < 64; o <<= 1) v += __shfl_xor(v, o);
    return v;
}


#define XB_TMO      128
#define XB_XCNT(j)  (256  + 64 * (j))
#define XB_XSUB(j)  (1280 + 64 * (j))
#define XB_XGEN(j)  (2304 + 64 * (j))
#define XB_TOP      3328
#define XB_TOPGEN   3392
#define XCD_BAR_WORDS 3456
#define XB_SPIN_CAP (1u << 22)
__device__ __forceinline__ unsigned xb_ld(unsigned* p)              { return __hip_atomic_load(p, __ATOMIC_RELAXED, __HIP_MEMORY_SCOPE_AGENT); }
__device__ __forceinline__ unsigned xb_add(unsigned* p, unsigned v) { return __hip_atomic_fetch_add(p, v, __ATOMIC_RELAXED, __HIP_MEMORY_SCOPE_AGENT); }
__device__ __forceinline__ unsigned xb_xcc_id() { return (unsigned)__builtin_amdgcn_s_getreg((3 << 11) | 20) & 0xFu; }
#define XB_SPIN(cond, bar) do { unsigned _sp = 0; while (cond) { __builtin_amdgcn_s_sleep(1); \
    if ((++_sp & 255u) == 0u) { if (xb_ld(&(bar)[XB_TMO])) break; if (_sp > XB_SPIN_CAP) { atomicAdd(&(bar)[XB_TMO], 1u); break; } } } } while (0)
struct XcdBarrier { unsigned* bar; unsigned x; volatile LAS unsigned* st; };
__device__ __forceinline__ XcdBarrier xcd_barrier_post(unsigned* bar, volatile LAS unsigned* st) {
    XcdBarrier b; b.bar = bar; b.x = xb_xcc_id(); b.st = st;
    if (threadIdx.x == 0) (void)xb_add(&bar[XB_XCNT(b.x)], 1u);
    return b;
}
__device__ __forceinline__ void xcd_barrier_complete(unsigned* bar, unsigned x, unsigned& nloc, unsigned& nx) {
    const unsigned G = gridDim.x * gridDim.y * gridDim.z;
    unsigned sum, cnt, mine, sp = 0u;
    for (;;) {
        sum = 0u; cnt = 0u; mine = 0u;
#pragma unroll
        for (unsigned j = 0; j < 16; ++j) { const unsigned c = xb_ld(&bar[XB_XCNT(j)]); sum += c; cnt += (c > 0u) ? 1u : 0u; mine = (j == x) ? c : mine; }
        if (sum == G) break;
        __builtin_amdgcn_s_sleep(1);
        if ((++sp & 255u) == 0u) { if (xb_ld(&bar[XB_TMO])) break; if (sp > XB_SPIN_CAP) { atomicAdd(&bar[XB_TMO], 1u); break; } }
    }
    nloc = mine > 0u ? mine : 1u; nx = cnt > 0u ? cnt : 1u;
}
__device__ __forceinline__ void xcd_barrier(const XcdBarrier& b) {
    asm volatile("s_waitcnt vmcnt(0)" ::: "memory");
    __syncthreads();
    if (threadIdx.x == 0) {
        unsigned* bar = b.bar;
        __builtin_amdgcn_s_waitcnt(0);
        unsigned nloc = b.st[0], nx = b.st[1];
        if (nloc == 0u) { xcd_barrier_complete(bar, b.x, nloc, nx); b.st[0] = nloc; b.st[1] = nx; }
        const unsigned old = xb_add(&bar[XB_XSUB(b.x)], 1u);
        const unsigned gen = old / nloc;
        if (old + 1u == (gen + 1u) * nloc) {
            __builtin_amdgcn_fence(__ATOMIC_RELEASE, "agent");
            asm volatile("s_waitcnt vmcnt(0)" ::: "memory");
            const unsigned og = xb_add(&bar[XB_TOP], 1u);
            const unsigned tg = og / nx;
            if (og + 1u == (tg + 1u) * nx) xb_add(&bar[XB_TOPGEN], 1u);
            else XB_SPIN(xb_ld(&bar[XB_TOPGEN]) == tg, bar);
            __builtin_amdgcn_fence(__ATOMIC_ACQUIRE, "agent");
            xb_add(&bar[XB_XGEN(b.x)], 1u);
            asm volatile("s_waitcnt vmcnt(0)" ::: "memory");
        } else {
            XB_SPIN(xb_ld(&bar[XB_XGEN(b.x)]) == gen, bar);
            __builtin_amdgcn_fence(__ATOMIC_ACQUIRE, "agent");
            asm volatile("s_waitcnt vmcnt(0)" ::: "memory");
        }
    }
    __syncthreads();
}

namespace pg8 {
constexpr int BM = 256, BK = 64, HALF = 128, HTB = HALF * BK * 2, STAGE_BYTES = 8 * HTB, NXCD = 8, WGM = 8;
__host__ __device__ __forceinline__ int lds_byte(int r, int c) { const int st = (r >> 4) * 2 + (c >> 5), rr = r & 15, cc = c & 31, ob = rr * 64 + cc * 2; return st * 1024 + (ob ^ (((ob >> 9) & 1) << 5)); }
__host__ __device__ __forceinline__ void stage_rc(int b, int& R, int& C) { const int st = b / 1024, sb = b % 1024, swz = sb ^ (((sb >> 9) & 1) << 5); R = (st >> 1) * 16 + swz / 64; C = (st & 1) * 32 + (swz % 64) / 2; }
__host__ __device__ __forceinline__ int perm32(int rho) { const int n = rho >> 4, i = rho & 15; return 8 * (i >> 2) + 4 * n + (i & 3); }

struct Unit { int pm, pn, ta, tb, part; };
struct Order {
    int nM, nN, nwg, G, c, dft;
    __device__ void init(int nM_, int nN_, int G_, int c_, int dft_) { nM = nM_; nN = nN_; nwg = nM * nN; G = G_; c = c_; dft = dft_; }
    __device__ bool next(int i, Unit& u) const {
        const long L = (long)((dft == 4) ? (i >> 1) : i) * G + c; if (L >= nwg) return false;
        u.part = 0;
        int wgid = (int)L; { const int q = nwg / NXCD, r = nwg % NXCD, xcd = wgid % NXCD, off = wgid / NXCD; wgid = (xcd < r ? xcd * (q + 1) : r * (q + 1) + (xcd - r) * q) + off; }
        if (dft == 2) { const int b = wgid >> 5, r = wgid & 31, half = r >> 4, jt = (r >> 2) & 3, pmi = r & 3;
            u.pm = b * 4 + pmi; u.pn = half * 4 + jt; u.ta = half * 4 + pmi; u.tb = b * 8 + half * 4 + jt; return true; }
        if (dft == 4) { const int part = i & 1, b = wgid >> 4, tm = (wgid >> 2) & 3, tn = wgid & 3;
            u.pm = b * 4 + tm; u.pn = tn; u.ta = part * 4 + tm; u.tb = part * 80 + b * 4 + tn; u.part = part; return true; }
        const int nig = WGM * nN, gid = wgid / nig, fm = gid * WGM, gsz = (nM - fm) < WGM ? (nM - fm) : WGM;
        u.pm = fm + ((wgid % nig) % gsz); u.pn = (wgid % nig) / gsz;
        if (dft == 5) { u.pn += 12; u.ta = u.pm; u.tb = u.pn; return true; }
        u.ta = dft ? (u.pm & 7) : u.pm; u.tb = dft ? ((u.pm >> 3) * 4 + u.pn) : u.pn;
        return true;
    }
};

template <class Epi, bool ALIGN_EPI, bool SP2, bool F8 = false>
__device__ __forceinline__ void gemm_phase(LAS unsigned char* lds, const bf16_t* gA, const bf16_t* gBt, const int K, const Order& S, const Epi& E) {
    int tid_ = threadIdx.x; asm volatile("" : "+v"(tid_));
    const int tid = tid_, wid = __builtin_amdgcn_readfirstlane(tid >> 6), lane = tid & 63, wr = wid >> 2, wc = wid & 3, fr = lane & 15, fq = lane >> 4;
    const int nt = K / BK;
    unsigned voffA, voffB;
    { int R, C; stage_rc(tid * 16, R, C); const int Rb = Epi::PERM ? ((R & ~31) + perm32(R & 31)) : R; voffA = (unsigned)(R * K + C) * 2u; voffB = (unsigned)(Rb * K + C) * 2u; }
    const size_t rstep = (size_t)64 * K * 2;
    const size_t kstep = (size_t)(BK * 2);
    const size_t hstep = (size_t)HALF * K * 2;
    const size_t tstep = 2 * hstep;
    const unsigned ldsw = (unsigned)wid * 1024u;
    const int aoff = lds_byte(wr * 64 + fr, fq * 8), boff = lds_byte(wc * 32 + fr, fq * 8);
#define PG8_SA(b, h) (((b) * 2 + (h)) * HTB)
#define PG8_SB(b, h) ((4 + (b) * 2 + (h)) * HTB)
#define PG8_STAGE(bufoff, gbase, voff) do { _Pragma("unroll") for (int _i = 0; _i < 2; ++_i) { unsigned _vo = (voff); asm volatile("" : "+v"(_vo));     \
        __builtin_amdgcn_global_load_lds((const unsigned*)((const char*)(gbase) + (size_t)_i * rstep + _vo), (LAS unsigned*)(lds + (bufoff) + ldsw + _i * 8192), 16, 0, 0); } } while (0)
#define PG8_LDA(dst, b, h) do { _Pragma("unroll") for (int m = 0; m < 4; ++m) dst[m] = __builtin_shufflevector(*(const LAS i32x4*)(lds + PG8_SA(b, h) + aoff + m * 2048), *(const LAS i32x4*)(lds + PG8_SA(b, h) + aoff + m * 2048 + 1024), 0, 1, 2, 3, 4, 5, 6, 7); } while (0)
#define PG8_LDB(dst, b, h) do { _Pragma("unroll") for (int n = 0; n < 2; ++n) dst[n] = __builtin_shufflevector(*(const LAS i32x4*)(lds + PG8_SB(b, h) + boff + n * 2048), *(const LAS i32x4*)(lds + PG8_SB(b, h) + boff + n * 2048 + 1024), 0, 1, 2, 3, 4, 5, 6, 7); } while (0)
#define PG8_HALF(v, k) __builtin_bit_cast(bf16x8, (k) ? __builtin_shufflevector(v, v, 4, 5, 6, 7) : __builtin_shufflevector(v, v, 0, 1, 2, 3))
#define PG8_MMA(ai, bj, At, Bt) do { __builtin_amdgcn_s_setprio(1); _Pragma("unroll") for (int m = 0; m < 4; ++m) _Pragma("unroll") for (int n = 0; n < 2; ++n) _Pragma("unroll") for (int k = 0; k < 2; ++k) \
        acc[ai][bj][m][n] = __builtin_amdgcn_mfma_f32_16x16x32_bf16(PG8_HALF(Bt[n], k), PG8_HALF(At[m], k), acc[ai][bj][m][n], 0, 0, 0); __builtin_amdgcn_s_setprio(0); } while (0)
#define PG8_MMA8(ai, bj, At, Bt) do { __builtin_amdgcn_s_setprio(1); _Pragma("unroll") for (int m = 0; m < 4; ++m) _Pragma("unroll") for (int n = 0; n < 2; ++n) \
        acc[ai][bj][m][n] = __builtin_amdgcn_mfma_scale_f32_16x16x128_f8f6f4(Bt[n], At[m], acc[ai][bj][m][n], 0, 0, 0, 0, 0, 0); __builtin_amdgcn_s_setprio(0); } while (0)
#define PG8_MM(ai, bj, At, Bt) do { if constexpr (F8) PG8_MMA8(ai, bj, At, Bt); else PG8_MMA(ai, bj, At, Bt); } while (0)
#define PG8_WAIT_V(n) asm volatile("s_waitcnt vmcnt(" #n ")" ::: "memory")
#define PG8_WAIT_L(n) asm volatile("s_waitcnt lgkmcnt(" #n ")" ::: "memory")
#define PG8_BAR __builtin_amdgcn_s_barrier()
#define PG8_SCHED __builtin_amdgcn_sched_barrier(0)
    Unit cur, nxt; int ui = 0;
    if (!S.next(0, cur)) return;
    f32x4 acc[2][2][4][2];
#pragma unroll
    for (int a = 0; a < 2; ++a)
#pragma unroll
        for (int b = 0; b < 2; ++b)
#pragma unroll
            for (int m = 0; m < 4; ++m)
#pragma unroll
                for (int n = 0; n < 2; ++n) acc[a][b][m][n] = (f32x4){0.f, 0.f, 0.f, 0.f};
    i32x8 At[4], B0[2], B1[2];
    const char* cA = (const char*)gA + (size_t)cur.ta * tstep; const char* cB = (const char*)gBt + (size_t)cur.tb * tstep;
    if constexpr (SP2) {
        PG8_STAGE(PG8_SB(0, 0), cB, voffB); PG8_STAGE(PG8_SB(0, 1), cB + hstep, voffB); PG8_STAGE(PG8_SA(0, 0), cA, voffA); PG8_STAGE(PG8_SA(0, 1), cA + hstep, voffA);
        if (wr == 1) PG8_BAR;
        PG8_WAIT_V(2); PG8_BAR;
        PG8_STAGE(PG8_SB(1, 0), cB + kstep, voffB); PG8_STAGE(PG8_SA(1, 0), cA + kstep, voffA); PG8_STAGE(PG8_SB(1, 1), cB + hstep + kstep, voffB);
        PG8_WAIT_V(6); PG8_BAR;
    } else {
        PG8_STAGE(PG8_SB(0, 0), cB, voffB); PG8_STAGE(PG8_SA(0, 0), cA, voffA); PG8_STAGE(PG8_SB(0, 1), cB + hstep, voffB); PG8_STAGE(PG8_SA(0, 1), cA + hstep, voffA);
        if (wr == 1) PG8_BAR;
        PG8_WAIT_V(4); PG8_BAR;
        PG8_STAGE(PG8_SB(1, 0), cB + kstep, voffB); PG8_STAGE(PG8_SA(1, 0), cA + kstep, voffA); PG8_STAGE(PG8_SB(1, 1), cB + hstep + kstep, voffB);
        PG8_WAIT_V(6); PG8_BAR;
    }
    for (;;) {
        const bool has_next = S.next(ui + 1, nxt);
        const char* nA = has_next ? (const char*)gA + (size_t)nxt.ta * tstep : cA; const char* nB = has_next ? (const char*)gBt + (size_t)nxt.tb * tstep : cB;
        for (int t = 0; t < nt; t += 2) {
            const bool last = (t == nt - 2);
            const char* a1 = cA + (size_t)(t + 1) * kstep;
            const char* a2 = last ? nA : cA + (size_t)(t + 2) * kstep; const char* b2 = last ? nB : cB + (size_t)(t + 2) * kstep;
            const char* a3 = a2 + kstep; const char* b3 = b2 + kstep;
            if constexpr (SP2) {
            PG8_LDB(B0, 0, 0); PG8_LDB(B1, 0, 1); PG8_SCHED; PG8_LDA(At, 0, 0); PG8_STAGE(PG8_SA(1, 1), a1 + hstep, voffA);
            PG8_WAIT_V(8); PG8_WAIT_L(0); PG8_BAR; PG8_MM(0, 0, At, B0); PG8_MM(0, 1, At, B1); PG8_BAR; PG8_SCHED;
            PG8_LDA(At, 0, 1); PG8_STAGE(PG8_SB(0, 0), b2, voffB); PG8_STAGE(PG8_SB(0, 1), b2 + hstep, voffB); PG8_STAGE(PG8_SA(0, 0), a2, voffA);
            PG8_WAIT_V(8); PG8_WAIT_L(0); PG8_BAR; PG8_MM(1, 0, At, B0); PG8_MM(1, 1, At, B1); PG8_BAR; PG8_SCHED;
            PG8_LDB(B0, 1, 0); PG8_LDB(B1, 1, 1); PG8_SCHED; PG8_LDA(At, 1, 0); PG8_STAGE(PG8_SA(0, 1), a2 + hstep, voffA);
            PG8_WAIT_V(8); PG8_WAIT_L(0); PG8_BAR; PG8_MM(0, 0, At, B0); PG8_MM(0, 1, At, B1); PG8_BAR; PG8_SCHED;
            PG8_LDA(At, 1, 1); PG8_STAGE(PG8_SB(1, 0), b3, voffB); PG8_STAGE(PG8_SB(1, 1), b3 + hstep, voffB); PG8_STAGE(PG8_SA(1, 0), a3, voffA);
            PG8_WAIT_V(8); PG8_WAIT_L(0); PG8_BAR; PG8_MM(1, 0, At, B0); PG8_MM(1, 1, At, B1); PG8_BAR; PG8_SCHED;
            } else {
            PG8_LDB(B0, 0, 0); PG8_SCHED; PG8_LDA(At, 0, 0); PG8_STAGE(PG8_SA(1, 1), a1 + hstep, voffA);
            PG8_WAIT_L(8); PG8_BAR; PG8_WAIT_L(0); PG8_MM(0, 0, At, B0); PG8_BAR; PG8_SCHED;
            PG8_LDB(B1, 0, 1); PG8_STAGE(PG8_SB(0, 0), b2, voffB);
            PG8_BAR; PG8_WAIT_L(0); PG8_MM(0, 1, At, B1); PG8_BAR;
            PG8_LDA(At, 0, 1); PG8_STAGE(PG8_SA(0, 0), a2, voffA);
            PG8_BAR; PG8_WAIT_L(0); PG8_MM(1, 0, At, B0); PG8_BAR; PG8_SCHED;
            PG8_STAGE(PG8_SB(0, 1), b2 + hstep, voffB);
            PG8_WAIT_V(6); PG8_BAR; PG8_MM(1, 1, At, B1); PG8_BAR;
            PG8_LDB(B0, 1, 0); PG8_SCHED; PG8_LDA(At, 1, 0); PG8_STAGE(PG8_SA(0, 1), a2 + hstep, voffA);
            PG8_WAIT_L(8); PG8_BAR; PG8_WAIT_L(0); PG8_MM(0, 0, At, B0); PG8_BAR; PG8_SCHED;
            PG8_LDB(B1, 1, 1); PG8_STAGE(PG8_SB(1, 0), b3, voffB);
            PG8_BAR; PG8_WAIT_L(0); PG8_MM(0, 1, At, B1); PG8_BAR;
            PG8_LDA(At, 1, 1); PG8_STAGE(PG8_SA(1, 0), a3, voffA);
            PG8_BAR; PG8_WAIT_L(0); PG8_MM(1, 0, At, B0); PG8_BAR; PG8_SCHED;
            PG8_STAGE(PG8_SB(1, 1), b3 + hstep, voffB);
            PG8_WAIT_V(6); PG8_BAR; PG8_MM(1, 1, At, B1); PG8_BAR;
            }
        }
        if constexpr (ALIGN_EPI) { if (wr == 0) PG8_BAR; }
        E(acc, cur, wr, wc, fr, fq);
        if (!has_next) break;
#pragma unroll
        for (int a = 0; a < 2; ++a)
#pragma unroll
            for (int b = 0; b < 2; ++b)
#pragma unroll
                for (int m = 0; m < 4; ++m)
#pragma unroll
                    for (int n = 0; n < 2; ++n) acc[a][b][m][n] = (f32x4){0.f, 0.f, 0.f, 0.f};
        cur = nxt; cA = nA; cB = nB; ++ui;
        if constexpr (ALIGN_EPI) { if (wr == 1) PG8_BAR; }
    }
    PG8_WAIT_V(0);
    if constexpr (!ALIGN_EPI) { if (wr == 0) PG8_BAR; }
    PG8_BAR;
#undef PG8_SA
#undef PG8_SB
#undef PG8_STAGE
#undef PG8_LDA
#undef PG8_LDB
#undef PG8_MMA
#undef PG8_HALF
#undef PG8_MMA8
#undef PG8_MM
#undef PG8_WAIT_V
#undef PG8_WAIT_L
#undef PG8_BAR
#undef PG8_SCHED
}

typedef const f32x4 (&AccRef)[2][2][4][2];
__device__ __forceinline__ u32x4 pack8(f32x4 v0, f32x4 v1) { u32x4 w; w.x = cvt_pk_bf16(v0[0], v0[1]); w.y = cvt_pk_bf16(v0[2], v0[3]); w.z = cvt_pk_bf16(v1[0], v1[1]); w.w = cvt_pk_bf16(v1[2], v1[3]); return w; }

struct EpiQKVG {
    static constexpr bool PERM = true;
    bf16_t* qkv; bf16_t* gate; const float* bgate; float gsc;
    __device__ __forceinline__ void operator()(AccRef acc, const Unit& u, int wr, int wc, int fr, int fq) const {
        const int row0 = u.pm * BM + wr * 64 + fr; const bool isg = u.pn >= 12;
        const float as = isg ? gsc : 1.0f;
        const float qs = (u.pn < 8) ? 0.08838834764831845f * LOG2E : 1.0f;
        const int col0 = (isg ? (u.pn - 12) : u.pn) * BM + wc * 32 + 8 * fq; bf16_t* base = isg ? gate : qkv; const int ldc = isg ? 4096 : 3072;
        f32x4 bv[2][2];
#pragma unroll
        for (int bj = 0; bj < 2; ++bj)
#pragma unroll
            for (int n = 0; n < 2; ++n) bv[bj][n] = isg ? *(const f32x4*)(bgate + col0 + bj * HALF + 4 * n) : (f32x4){0.f, 0.f, 0.f, 0.f};
#pragma unroll
        for (int ai = 0; ai < 2; ++ai)
#pragma unroll
            for (int m = 0; m < 4; ++m) { bf16_t* rowp = base + (size_t)(row0 + ai * HALF + m * 16) * ldc + col0;
#pragma unroll
                for (int bj = 0; bj < 2; ++bj) { f32x4 v0 = (acc[ai][bj][m][0] * as + bv[bj][0]) * qs, v1 = (acc[ai][bj][m][1] * as + bv[bj][1]) * qs;
                    if (isg) {
#pragma unroll
                        for (int j = 0; j < 4; ++j) { v0[j] = sigmoidf_(v0[j]); v1[j] = sigmoidf_(v1[j]); } }
                    *(u32x4*)(rowp + bj * HALF) = pack8(v0, v1); } }
    }
};
struct EpiGate8 {
    static constexpr bool PERM = true;
    bf16_t* gate; const float* bgate;
    __device__ __forceinline__ void operator()(AccRef acc, const Unit& u, int wr, int wc, int fr, int fq) const {
        const int row0 = u.pm * BM + wr * 64 + fr, col0 = u.pn * BM + wc * 32 + 8 * fq;
        f32x4 bv[2][2];
#pragma unroll
        for (int bj = 0; bj < 2; ++bj)
#pragma unroll
            for (int n = 0; n < 2; ++n) bv[bj][n] = *(const f32x4*)(bgate + col0 + bj * HALF + 4 * n);
#pragma unroll
        for (int ai = 0; ai < 2; ++ai)
#pragma unroll
            for (int m = 0; m < 4; ++m) { bf16_t* rowp = gate + (size_t)(row0 + ai * HALF + m * 16) * 4096 + col0;
#pragma unroll
                for (int bj = 0; bj < 2; ++bj) { f32x4 v0 = acc[ai][bj][m][0] * 0.00390625f + bv[bj][0], v1 = acc[ai][bj][m][1] * 0.00390625f + bv[bj][1];
#pragma unroll
                    for (int j = 0; j < 4; ++j) { v0[j] = sigmoidf_(v0[j]); v1[j] = sigmoidf_(v1[j]); }
                    *(u32x4*)(rowp + bj * HALF) = pack8(v0, v1); } }
    }
};
struct EpiBf16 {
    static constexpr bool PERM = true;
    bf16_t* out; int ld; int ut;
    __device__ __forceinline__ void operator()(AccRef acc, const Unit& u, int wr, int wc, int fr, int fq) const {
        size_t tb;
        if (ut == 1) { const int part = u.pm >> 2, cbase = (u.pm & 3) * 256, b = u.pn >> 3, sbase = (u.pn & 7) * 256; tb = ((size_t)(b * 1024 + cbase) * 2 + part) * 2048 + sbase; }
        else if (ut == 2) tb = (size_t)(u.pn >> 2) * ((size_t)NBATCH * 1024 * 1024) + (size_t)u.pm * BM * 1024 + (size_t)(u.pn & 3) * BM;
        else tb = (size_t)u.pm * BM * ld + (size_t)u.pn * BM;
        bf16_t* p0 = out + tb + (size_t)(wr * 64 + fr) * ld + wc * 32 + 8 * fq;
#pragma unroll
        for (int ai = 0; ai < 2; ++ai)
#pragma unroll
            for (int m = 0; m < 4; ++m) { bf16_t* rowp = p0 + (size_t)(ai * HALF + m * 16) * ld;
#pragma unroll
                for (int bj = 0; bj < 2; ++bj) *(u32x4*)(rowp + bj * HALF) = pack8(acc[ai][bj][m][0], acc[ai][bj][m][1]); }
    }
};
struct EpiRE {
    static constexpr bool PERM = true;
    bf16_t* out; const float* u1024;
    __device__ __forceinline__ void operator()(AccRef acc, const Unit& u, int wr, int wc, int fr, int fq) const {
        const int col0 = u.pn * BM + wc * 32 + 8 * fq; const float sg = (fr & 1) ? -1.0f : 1.0f;
        const float* up = u1024 + (size_t)(u.pm >> 3) * 1024 + col0;
        f32x4 uv[2][2];
#pragma unroll
        for (int bj = 0; bj < 2; ++bj)
#pragma unroll
            for (int n = 0; n < 2; ++n) uv[bj][n] = *(const f32x4*)(up + bj * HALF + 4 * n) * sg;
        bf16_t* p0 = out + ((size_t)u.pm * BM + wr * 64 + fr) * 1024 + col0;
#pragma unroll
        for (int ai = 0; ai < 2; ++ai)
#pragma unroll
            for (int m = 0; m < 4; ++m) { bf16_t* rowp = p0 + (size_t)(ai * HALF + m * 16) * 1024;
#pragma unroll
                for (int bj = 0; bj < 2; ++bj) *(u32x4*)(rowp + bj * HALF) = pack8(acc[ai][bj][m][0] + uv[bj][0], acc[ai][bj][m][1] + uv[bj][1]); }
    }
};
struct EpiREsym {
    static constexpr bool PERM = true;
    bf16_t* out; bf16_t* tmp2; const float* u1024;
    __device__ __forceinline__ void operator()(AccRef acc, const Unit& u, int wr, int wc, int fr, int fq) const {
        const int col0 = u.pn * BM + wc * 32 + 8 * fq, b = u.pm >> 2, t0 = (u.pm & 3) * BM + wr * 64 + fr;
        bf16_t* tp0 = tmp2 + ((size_t)u.pm * BM + wr * 64 + fr) * 1024 + col0;
        if (u.part == 0) {
#pragma unroll
            for (int ai = 0; ai < 2; ++ai)
#pragma unroll
                for (int m = 0; m < 4; ++m)
#pragma unroll
                    for (int bj = 0; bj < 2; ++bj) *(u32x4*)(tp0 + (size_t)(ai * HALF + m * 16) * 1024 + bj * HALF) = pack8(acc[ai][bj][m][0], acc[ai][bj][m][1]);
            return;
        }
        const float sg = (fr & 1) ? -1.0f : 1.0f; const float* up = u1024 + (size_t)b * 1024 + col0;
        f32x4 uv[2][2];
#pragma unroll
        for (int bj = 0; bj < 2; ++bj)
#pragma unroll
            for (int n = 0; n < 2; ++n) uv[bj][n] = *(const f32x4*)(up + bj * HALF + 4 * n) * sg;
#pragma unroll
        for (int ai = 0; ai < 2; ++ai)
#pragma unroll
            for (int m = 0; m < 4; ++m) { const int t = t0 + ai * HALF + m * 16;
                bf16_t* lo = out + ((size_t)b * SEQ + t) * 1024 + col0; bf16_t* hi = out + ((size_t)b * SEQ + (SEQ - t)) * 1024 + col0;
#pragma unroll
                for (int bj = 0; bj < 2; ++bj) { const u32x4 pw = *(const u32x4*)(tp0 + (size_t)(ai * HALF + m * 16) * 1024 + bj * HALF);
                    const f32x4 p0 = (f32x4){bf_lo(pw.x), bf_hi(pw.x), bf_lo(pw.y), bf_hi(pw.y)} + uv[bj][0], p1 = (f32x4){bf_lo(pw.z), bf_hi(pw.z), bf_lo(pw.w), bf_hi(pw.w)} + uv[bj][1];
                    *(u32x4*)(lo + bj * HALF) = pack8(p0 + acc[ai][bj][m][0], p1 + acc[ai][bj][m][1]);
                    if (t != 0) *(u32x4*)(hi + bj * HALF) = pack8(p0 - acc[ai][bj][m][0], p1 - acc[ai][bj][m][1]); } }
    }
};
template <int PART> struct EpiMerge {
    static constexpr bool PERM = true;
    const bf16_t* G; const bf16_t* tmp_in; bf16_t* out;
    __device__ __forceinline__ void operator()(AccRef acc, const Unit& u, int wr, int wc, int fr, int fq) const {
        const int row0 = u.pm * BM + wr * 64 + fr, col0 = u.pn * BM + wc * 32 + 8 * fq;
#pragma unroll
        for (int ai = 0; ai < 2; ++ai)
#pragma unroll
            for (int m = 0; m < 4; ++m) { const size_t row = (size_t)(row0 + ai * HALF + m * 16);
#pragma unroll
                for (int bj = 0; bj < 2; ++bj) { const int col = col0 + bj * HALF;
                    const u32x4 g = *(const u32x4*)(G + row * 4096 + PART * 2048 + col);
                    f32x4 v0 = acc[ai][bj][m][0], v1 = acc[ai][bj][m][1];
                    v0[0] *= bf_lo(g.x); v0[1] *= bf_hi(g.x); v0[2] *= bf_lo(g.y); v0[3] *= bf_hi(g.y); v1[0] *= bf_lo(g.z); v1[1] *= bf_hi(g.z); v1[2] *= bf_lo(g.w); v1[3] *= bf_hi(g.w);
                    if (PART == 1) { const u32x4 t = *(const u32x4*)(tmp_in + row * 2048 + col);
                        v0[0] += bf_lo(t.x); v0[1] += bf_hi(t.x); v0[2] += bf_lo(t.y); v0[3] += bf_hi(t.y); v1[0] += bf_lo(t.z); v1[1] += bf_hi(t.z); v1[2] += bf_lo(t.w); v1[3] += bf_hi(t.w); }
                    *(u32x4*)(out + row * 2048 + col) = pack8(v0, v1); } }
    }
};
struct EpiRes {
    static constexpr bool PERM = false;
    const float* base0; const float* base1; int split; const float* gate; float* out;
    __device__ __forceinline__ void operator()(AccRef acc, const Unit& u, int wr, int wc, int fr, int fq) const {
        const int rl0 = wr * 64 + fr, col0 = u.pn * BM + wc * 32 + 4 * fq;
        const float* bp = (u.pm < split) ? base0 + (size_t)u.pm * BM * DM : base1 + (size_t)(u.pm - split) * BM * DM;
        float* op = out + (size_t)u.pm * BM * DM; const float* gp = gate + (size_t)(u.pm >> 3) * NMOD + col0;
        f32x4 gv[2][2];
#pragma unroll
        for (int bj = 0; bj < 2; ++bj)
#pragma unroll
            for (int n = 0; n < 2; ++n) gv[bj][n] = *(const f32x4*)(gp + bj * HALF + n * 16);
#pragma unroll
        for (int aim = 0; aim < 4; ++aim) {
            const int ai = aim >> 1, mb = (aim & 1) * 2;
            f32x4 bs[2][2][2];
#pragma unroll
            for (int m = 0; m < 2; ++m) { const size_t off = (size_t)(rl0 + ai * HALF + (mb + m) * 16) * DM + col0;
#pragma unroll
                for (int bj = 0; bj < 2; ++bj)
#pragma unroll
                    for (int n = 0; n < 2; ++n) bs[m][bj][n] = *(const f32x4*)(bp + off + bj * HALF + n * 16); }
#pragma unroll
            for (int m = 0; m < 2; ++m) { const size_t off = (size_t)(rl0 + ai * HALF + (mb + m) * 16) * DM + col0;
#pragma unroll
                for (int bj = 0; bj < 2; ++bj)
#pragma unroll
                    for (int n = 0; n < 2; ++n) *(f32x4*)(op + off + bj * HALF + n * 16) = bs[m][bj][n] + gv[bj][n] * acc[ai][bj][mb + m][n]; }
            asm volatile("" ::: "memory"); }
    }
};
template <int MODE> struct EpiResT {
    static constexpr bool PERM = true;
    const float* base0; const float* base1; int split; const bf16_t* base16; const float* gate; float* out32; bf16_t* out16;
    __device__ __forceinline__ void operator()(AccRef acc, const Unit& u, int wr, int wc, int fr, int fq) const {
        const int rl0 = wr * 64 + fr, col0 = u.pn * BM + wc * 32 + 8 * fq;
        const float* gp = gate + (size_t)(u.pm >> 3) * NMOD + col0;
        f32x4 gv[2][2];
#pragma unroll
        for (int bj = 0; bj < 2; ++bj)
#pragma unroll
            for (int n = 0; n < 2; ++n) gv[bj][n] = *(const f32x4*)(gp + bj * HALF + 4 * n);
        if constexpr (MODE == 1) {
            const float* bp = (u.pm < split) ? base0 + (size_t)u.pm * BM * DM : base1 + (size_t)(u.pm - split) * BM * DM;
            bf16_t* op = out16 + (size_t)u.pm * BM * DM;
#pragma unroll
            for (int aim = 0; aim < 4; ++aim) {
                const int ai = aim >> 1, mb = (aim & 1) * 2;
                f32x4 bs[2][2][2];
#pragma unroll
                for (int m = 0; m < 2; ++m) { const size_t off = (size_t)(rl0 + ai * HALF + (mb + m) * 16) * DM + col0;
#pragma unroll
                    for (int bj = 0; bj < 2; ++bj)
#pragma unroll
                        for (int n = 0; n < 2; ++n) bs[m][bj][n] = *(const f32x4*)(bp + off + bj * HALF + 4 * n); }
#pragma unroll
                for (int m = 0; m < 2; ++m) { const size_t off = (size_t)(rl0 + ai * HALF + (mb + m) * 16) * DM + col0;
#pragma unroll
                    for (int bj = 0; bj < 2; ++bj) *(u32x4*)(op + off + bj * HALF) = pack8(bs[m][bj][0] + gv[bj][0] * acc[ai][bj][mb + m][0], bs[m][bj][1] + gv[bj][1] * acc[ai][bj][mb + m][1]); }
                asm volatile("" ::: "memory"); }
        } else {
            const bf16_t* bp = base16 + (size_t)u.pm * BM * DM; float* op = out32 + (size_t)u.pm * BM * DM;
#pragma unroll
            for (int ai = 0; ai < 2; ++ai) {
                u32x4 t[4][2];
#pragma unroll
                for (int m = 0; m < 4; ++m) { const size_t off = (size_t)(rl0 + ai * HALF + m * 16) * DM + col0;
#pragma unroll
                    for (int bj = 0; bj < 2; ++bj) t[m][bj] = *(const u32x4*)(bp + off + bj * HALF); }
#pragma unroll
                for (int m = 0; m < 4; ++m) { const size_t off = (size_t)(rl0 + ai * HALF + m * 16) * DM + col0;
#pragma unroll
                    for (int bj = 0; bj < 2; ++bj) { const u32x4 w = t[m][bj];
                        *(f32x4*)(op + off + bj * HALF) = (f32x4){bf_lo(w.x), bf_hi(w.x), bf_lo(w.y), bf_hi(w.y)} + gv[bj][0] * acc[ai][bj][m][0];
                        *(f32x4*)(op + off + bj * HALF + 4) = (f32x4){bf_lo(w.z), bf_hi(w.z), bf_lo(w.w), bf_hi(w.w)} + gv[bj][1] * acc[ai][bj][m][1]; } }
                asm volatile("" ::: "memory"); }
        }
    }
};
struct EpiSwiGLU {
    static constexpr bool PERM = false;
    bf16_t* act;
    __device__ __forceinline__ void operator()(AccRef acc, const Unit& u, int wr, int wc, int fr, int fq) const {
        bf16_t* p0 = act + (size_t)(u.pm * BM + wr * 64 + fr) * DFF + u.pn * 128 + wc * 32 + 8 * fq;
#pragma unroll
        for (int ai = 0; ai < 2; ++ai)
#pragma unroll
            for (int m = 0; m < 4; ++m) { f32x4 o[2];
#pragma unroll
                for (int bj = 0; bj < 2; ++bj)
#pragma unroll
                    for (int j = 0; j < 4; ++j) { const float g = acc[ai][bj][m][0][j]; o[bj][j] = g * sigmoidf_(g) * acc[ai][bj][m][1][j]; }
                *(u32x4*)(p0 + (size_t)(ai * HALF + m * 16) * DFF) = pack8(o[0], o[1]); }
    }
};
}

struct Args {
    const float *xp, *xs, *cp, *cs, *w_mod, *b_mod, *g_mix, *w_in, *sink, *w_attn, *w_four, *w_gate, *b_gate, *w_out, *g_ffn, *w_up, *w_down, *g_final;
    float* out; unsigned char* ws;
};

struct SrcIdent { __device__ __forceinline__ int operator()(int R) const { return R; } };
struct SrcUp { __device__ __forceinline__ int operator()(int R) const {
    const int pn = R >> 8, r = R & 255, bj = r >> 7, wc = (r >> 5) & 3, n = (r >> 4) & 1, i = r & 15, fq = i >> 2, j = i & 3;
    return (n ? DFF : 0) + 128 * pn + 32 * wc + 8 * fq + 4 * bj + j; } };
template <class Src> __device__ __forceinline__ void transpose_item(const float* W, int ldw, int K, bf16_t* WT, int nrows, int row_off, const Src src, LAS float* scr, int item, int lane) {
    const int nblk = nrows / 32, kb = item / nblk, nb = item % nblk, k0 = 64 * kb, n0 = 32 * nb;
    const int sc = src(n0 + (lane & 31));
#pragma unroll 8
    for (int i = 0; i < 32; ++i) { const int kk = 2 * i + (lane >> 5); scr[kk * 33 + (lane & 31)] = W[(size_t)(k0 + kk) * ldw + sc]; }
    asm volatile("s_waitcnt lgkmcnt(0)" ::: "memory");
    const int c = lane & 7;
#pragma unroll
    for (int j = 0; j < 4; ++j) { const int n = (lane >> 3) + 8 * j; const LAS float* s = scr + (8 * c) * 33 + n;
        u32x4 o; o.x = cvt_pk_bf16(s[0 * 33], s[1 * 33]); o.y = cvt_pk_bf16(s[2 * 33], s[3 * 33]); o.z = cvt_pk_bf16(s[4 * 33], s[5 * 33]); o.w = cvt_pk_bf16(s[6 * 33], s[7 * 33]);
        *(u32x4*)(WT + (size_t)(row_off + n0 + n) * K + k0 + 8 * c) = o; }
    asm volatile("s_waitcnt lgkmcnt(0)" ::: "memory");
}

__device__ __forceinline__ void transpose_item_fp8(const float* W, int ldw, int K, unsigned char* WT, int nrows, float scale, LAS float* scr, int item, int lane) {
    const int nblk = nrows / 32, kb = item / nblk, nb = item % nblk, k0 = 64 * kb, n0 = 32 * nb;
#pragma unroll 8
    for (int i = 0; i < 32; ++i) { const int kk = 2 * i + (lane >> 5); scr[kk * 33 + (lane & 31)] = W[(size_t)(k0 + kk) * ldw + n0 + (lane & 31)]; }
    asm volatile("s_waitcnt lgkmcnt(0)" ::: "memory");
    const int c = lane & 3;
#pragma unroll
    for (int q = 0; q < 2; ++q) { const int n = (lane >> 2) + 16 * q; const LAS float* s = scr + (16 * c) * 33 + n;
        u32x4 o; o.x = pk_fp8x4(s[0 * 33] * scale, s[1 * 33] * scale, s[2 * 33] * scale, s[3 * 33] * scale); o.y = pk_fp8x4(s[4 * 33] * scale, s[5 * 33] * scale, s[6 * 33] * scale, s[7 * 33] * scale);
        o.z = pk_fp8x4(s[8 * 33] * scale, s[9 * 33] * scale, s[10 * 33] * scale, s[11 * 33] * scale); o.w = pk_fp8x4(s[12 * 33] * scale, s[13 * 33] * scale, s[14 * 33] * scale, s[15 * 33] * scale);
        *(u32x4*)(WT + (size_t)(n0 + n) * K + k0 + 16 * c) = o; }
    asm volatile("s_waitcnt lgkmcnt(0)" ::: "memory");
}

template <bool OUT_BF16, bool HAS_MOD>
__device__ __forceinline__ void norm_rows(const float* src0, const float* src1, const float* g, const float* mod_shift, const float* mod_scale, void* outp, int gw, int NGW, int lane) {
    asm volatile("" : "+v"(lane));
    for (int m0 = gw; m0 < MTOK; m0 += 2 * NGW) {
        const int m1 = m0 + NGW; const bool has1 = m1 < MTOK; const int m1c = has1 ? m1 : m0;
        const float* xr0 = (m0 < NPR) ? src0 + (size_t)m0 * DM : src1 + (size_t)(m0 - NPR) * DM;
        const float* xr1 = (m1c < NPR) ? src0 + (size_t)m1c * DM : src1 + (size_t)(m1c - NPR) * DM;
        f32x4 v0[8], v1[8]; float s0 = 0.f, s1 = 0.f;
#pragma unroll
        for (int j = 0; j < 8; ++j) { v0[j] = __builtin_nontemporal_load((const f32x4*)xr0 + lane + 64 * j); v1[j] = __builtin_nontemporal_load((const f32x4*)xr1 + lane + 64 * j); }
#pragma unroll
        for (int j = 0; j < 8; ++j) { s0 += (v0[j].x * v0[j].x + v0[j].y * v0[j].y) + (v0[j].z * v0[j].z + v0[j].w * v0[j].w); s1 += (v1[j].x * v1[j].x + v1[j].y * v1[j].y) + (v1[j].z * v1[j].z + v1[j].w * v1[j].w); }
#pragma unroll
        for (int o = 1; o < 64; o <<= 1) { s0 += __shfl_xor(s0, o); s1 += __shfl_xor(s1, o); }
        const float r0 = 1.0f / sqrtf(s0 * (1.0f / DM) + RMS_EPS), r1 = 1.0f / sqrtf(s1 * (1.0f / DM) + RMS_EPS);
        const int b0 = m0 >> 11, b1 = m1c >> 11;
#pragma unroll
        for (int j = 0; j < 8; ++j) { const int col = 4 * lane + 256 * j; const f32x4 gg = *(const f32x4*)(g + col);
            f32x4 y0 = v0[j] * r0 * gg, y1 = v1[j] * r1 * gg;
            if (HAS_MOD) { const f32x4 sc0 = *(const f32x4*)(mod_scale + (size_t)b0 * NMOD + col), sh0 = *(const f32x4*)(mod_shift + (size_t)b0 * NMOD + col); y0 = y0 * (1.0f + sc0) + sh0;
                           const f32x4 sc1 = *(const f32x4*)(mod_scale + (size_t)b1 * NMOD + col), sh1 = *(const f32x4*)(mod_shift + (size_t)b1 * NMOD + col); y1 = y1 * (1.0f + sc1) + sh1; }
            if (OUT_BF16) { u32x2 w; w.x = cvt_pk_bf16(y0.x, y0.y); w.y = cvt_pk_bf16(y0.z, y0.w); *(u32x2*)((bf16_t*)outp + (size_t)m0 * DM + col) = w;
                            if (has1) { u32x2 w1; w1.x = cvt_pk_bf16(y1.x, y1.y); w1.y = cvt_pk_bf16(y1.z, y1.w); *(u32x2*)((bf16_t*)outp + (size_t)m1 * DM + col) = w1; } }
            else { __builtin_nontemporal_store(y0, (f32x4*)((float*)outp + (size_t)m0 * DM + col)); if (has1) __builtin_nontemporal_store(y1, (f32x4*)((float*)outp + (size_t)m1 * DM + col)); } }
    }
}


__device__ __forceinline__ void norm_pair_rows(const float* src0, const float* src1, const float* g, const float* mod_shift, const float* mod_scale, bf16_t* Hout, bf16_t* HF, unsigned char* H8, int gw, int NGW, int lane) {
    asm volatile("" : "+v"(lane));
    for (int it = gw; it < NBATCH * 1025; it += NGW) {
        const int b = it / 1025, s = it - b * 1025, p = (2048 - s) & 2047;
        const int m0 = b * SEQ + s, m1 = b * SEQ + p;
        const float* xr0 = (m0 < NPR) ? src0 + (size_t)m0 * DM : src1 + (size_t)(m0 - NPR) * DM;
        const float* xr1 = (m1 < NPR) ? src0 + (size_t)m1 * DM : src1 + (size_t)(m1 - NPR) * DM;
        f32x4 v0[8], v1[8]; float s0 = 0.f, s1 = 0.f;
#pragma unroll
        for (int j = 0; j < 8; ++j) { v0[j] = __builtin_nontemporal_load((const f32x4*)xr0 + lane + 64 * j); v1[j] = __builtin_nontemporal_load((const f32x4*)xr1 + lane + 64 * j); }
#pragma unroll
        for (int j = 0; j < 8; ++j) { s0 += (v0[j].x * v0[j].x + v0[j].y * v0[j].y) + (v0[j].z * v0[j].z + v0[j].w * v0[j].w); s1 += (v1[j].x * v1[j].x + v1[j].y * v1[j].y) + (v1[j].z * v1[j].z + v1[j].w * v1[j].w); }
#pragma unroll
        for (int o = 1; o < 64; o <<= 1) { s0 += __shfl_xor(s0, o); s1 += __shfl_xor(s1, o); }
        const float r0 = 1.0f / sqrtf(s0 * (1.0f / DM) + RMS_EPS), r1 = 1.0f / sqrtf(s1 * (1.0f / DM) + RMS_EPS);
        const bool pair = (p != s), fold = (s < 1024);
#pragma unroll
        for (int j = 0; j < 8; ++j) { const int col = 4 * lane + 256 * j; const f32x4 gg = *(const f32x4*)(g + col);
            const f32x4 sc = *(const f32x4*)(mod_scale + (size_t)b * NMOD + col), sh = *(const f32x4*)(mod_shift + (size_t)b * NMOD + col);
            const f32x4 y0 = v0[j] * r0 * gg * (1.0f + sc) + sh, y1 = v1[j] * r1 * gg * (1.0f + sc) + sh;
            u32x2 w; w.x = cvt_pk_bf16(y0.x, y0.y); w.y = cvt_pk_bf16(y0.z, y0.w); *(u32x2*)(Hout + (size_t)m0 * DM + col) = w;
            *(unsigned*)(H8 + (size_t)m0 * DM + col) = pk_fp8x4(y0.x * 4.0f, y0.y * 4.0f, y0.z * 4.0f, y0.w * 4.0f);
            if (pair) { u32x2 w1; w1.x = cvt_pk_bf16(y1.x, y1.y); w1.y = cvt_pk_bf16(y1.z, y1.w); *(u32x2*)(Hout + (size_t)m1 * DM + col) = w1;
                        *(unsigned*)(H8 + (size_t)m1 * DM + col) = pk_fp8x4(y1.x * 4.0f, y1.y * 4.0f, y1.z * 4.0f, y1.w * 4.0f); }
            if (fold) { const f32x4 pl = pair ? (y0 + y1) : y0, mi = y0 - y1;
                u32x2 wp, wm; wp.x = cvt_pk_bf16(pl.x, pl.y); wp.y = cvt_pk_bf16(pl.z, pl.w); wm.x = cvt_pk_bf16(mi.x, mi.y); wm.y = cvt_pk_bf16(mi.z, mi.w);
                *(u32x2*)(HF + ((size_t)b * SEQ + s) * DM + col) = wp; *(u32x2*)(HF + ((size_t)b * SEQ + 1024 + s) * DM + col) = wm; } }
    }
}


__device__ __forceinline__ void norm_rows_bf16src(const bf16_t* src, const float* g, const float* mod_shift, const float* mod_scale, bf16_t* outp, int gw, int NGW, int lane) {
    asm volatile("" : "+v"(lane));
    for (int m0 = gw; m0 < MTOK; m0 += 2 * NGW) {
        const int m1 = m0 + NGW; const bool has1 = m1 < MTOK; const int m1c = has1 ? m1 : m0;
        const u32x4* p0 = (const u32x4*)(src + (size_t)m0 * DM); const u32x4* p1 = (const u32x4*)(src + (size_t)m1c * DM);
        u32x4 w0[4], w1[4]; float s0 = 0.f, s1 = 0.f;
#pragma unroll
        for (int j = 0; j < 4; ++j) { w0[j] = __builtin_nontemporal_load(p0 + lane + 64 * j); w1[j] = __builtin_nontemporal_load(p1 + lane + 64 * j); }
#pragma unroll
        for (int j = 0; j < 4; ++j)
#pragma unroll
            for (int e = 0; e < 4; ++e) { const float a0 = bf_lo(w0[j][e]), b0 = bf_hi(w0[j][e]), a1 = bf_lo(w1[j][e]), b1 = bf_hi(w1[j][e]); s0 += a0 * a0 + b0 * b0; s1 += a1 * a1 + b1 * b1; }
#pragma unroll
        for (int o = 1; o < 64; o <<= 1) { s0 += __shfl_xor(s0, o); s1 += __shfl_xor(s1, o); }
        const float r0 = 1.0f / sqrtf(s0 * (1.0f / DM) + RMS_EPS), r1 = 1.0f / sqrtf(s1 * (1.0f / DM) + RMS_EPS);
        const int b0i = m0 >> 11, b1i = m1c >> 11;
#pragma unroll
        for (int j = 0; j < 4; ++j) { const int col = 8 * lane + 512 * j; f32x4 y0[2], y1[2];
#pragma unroll
            for (int hh = 0; hh < 2; ++hh) { const int c4 = col + 4 * hh; const f32x4 gg = *(const f32x4*)(g + c4);
                const f32x4 sc0 = *(const f32x4*)(mod_scale + (size_t)b0i * NMOD + c4), sh0 = *(const f32x4*)(mod_shift + (size_t)b0i * NMOD + c4);
                const f32x4 sc1 = *(const f32x4*)(mod_scale + (size_t)b1i * NMOD + c4), sh1 = *(const f32x4*)(mod_shift + (size_t)b1i * NMOD + c4);
                const f32x4 x0 = (f32x4){bf_lo(w0[j][2 * hh]), bf_hi(w0[j][2 * hh]), bf_lo(w0[j][2 * hh + 1]), bf_hi(w0[j][2 * hh + 1])};
                const f32x4 x1 = (f32x4){bf_lo(w1[j][2 * hh]), bf_hi(w1[j][2 * hh]), bf_lo(w1[j][2 * hh + 1]), bf_hi(w1[j][2 * hh + 1])};
                y0[hh] = x0 * r0 * gg * (1.0f + sc0) + sh0; y1[hh] = x1 * r1 * gg * (1.0f + sc1) + sh1; }
            *(u32x4*)(outp + (size_t)m0 * DM + col) = pg8::pack8(y0[0], y0[1]);
            if (has1) *(u32x4*)(outp + (size_t)m1 * DM + col) = pg8::pack8(y1[0], y1[1]); }
    }
}

__device__ __forceinline__ void attn_phase(LAS unsigned char* lds, const bf16_t* QKV, bf16_t* AO, const float* sink, int ubeg, int uend, int ustep) {
    int tid_ = threadIdx.x; asm volatile("" : "+v"(tid_));
    const int tid = tid_, lane = tid & 63, wid = __builtin_amdgcn_readfirstlane(tid >> 6);
    const int r = lane & 31, h = lane >> 5, hg = wid >> 1, w2 = wid & 1;
    constexpr int KPB = 272, VPB = 136, CHB = 17408;
    LAS unsigned char* Kb = lds; LAS unsigned char* Vb = lds + 2 * CHB; LAS unsigned char* Ow = lds + 4 * CHB + wid * (32 * KPB);
    int cc = 0;
    for (int u = ubeg; u < uend; u += ustep) {
        const int b = u >> 7, kvh = (u >> 5) & 3, qb = u & 31, a0 = qb * 64, q0 = a0 + 32 * w2, hq = kvh * 4 + hg;
        const float slope2 = exp2f(-0.5f * (float)(hq + 1)) * LOG2E, sink2 = sink[hq] * LOG2E;
        bf16x8 qf[8];
        { const bf16_t* qrow = QKV + (size_t)(b * SEQ + q0 + r) * 3072 + hq * 128 + 8 * h;
#pragma unroll
          for (int ks = 0; ks < 8; ++ks) qf[ks] = *(const bf16x8*)(qrow + 16 * ks); }
        f32x16 ot[4];
#pragma unroll
        for (int dt = 0; dt < 4; ++dt)
#pragma unroll
            for (int i = 0; i < 16; ++i) ot[dt][i] = 0.f;
        float m_run = sink2, l_run = 1.0f;
        const int jlo = (2 - qb) > 0 ? (2 - qb) : 0, jhi = (33 - qb) < 4 ? (33 - qb) : 4;
        u32x4 kreg[1][2], vreg[1][2];
        const int kp = tid & 31, dg = tid >> 5;
#define ATT_LOAD(S_, j) do { const size_t tokb = (size_t)(b * SEQ + a0 - 128 + 64 * (j)); \
            _Pragma("unroll") for (int i = 0; i < 2; ++i) { const int p = tid + 512 * i; kreg[S_][i] = *(const u32x4*)(QKV + (tokb + (p >> 4)) * 3072 + 2048 + kvh * 128 + (p & 15) * 8); } \
            _Pragma("unroll") for (int i = 0; i < 2; ++i) vreg[S_][i] = *(const u32x4*)(QKV + (tokb + 2 * kp + i) * 3072 + 2560 + kvh * 128 + dg * 8); } while (0)
        ATT_LOAD(0, jlo);
        for (int j = jlo; j <= jhi; j += 2) {
#pragma unroll
          for (int sub = 0; sub < 2; ++sub) {
            const int jj = j + sub; if (jj > jhi) break;
            LAS unsigned char* Kc = Kb + (cc & 1) * CHB; LAS unsigned char* Vc = Vb + (cc & 1) * CHB; ++cc;
#pragma unroll
            for (int i = 0; i < 2; ++i) { const int p = tid + 512 * i; *(LAS u32x4*)(Kc + (p >> 4) * KPB + (p & 15) * 16) = kreg[0][i]; }
#pragma unroll
            for (int w = 0; w < 4; ++w) { const unsigned x0 = vreg[0][0][w], x1 = vreg[0][1][w];
                *(LAS unsigned*)(Vc + (8 * dg + 2 * w) * VPB + kp * 4) = (x0 & 0xffffu) | (x1 << 16);
                *(LAS unsigned*)(Vc + (8 * dg + 2 * w + 1) * VPB + kp * 4) = (x0 >> 16) | (x1 & 0xffff0000u); }
            __syncthreads();
            if (jj + 1 <= jhi) ATT_LOAD(0, jj + 1);
            f32x16 st[2];
#pragma unroll
            for (int kt = 0; kt < 2; ++kt)
#pragma unroll
                for (int i = 0; i < 16; ++i) st[kt][i] = 0.f;
            {
                bf16x8 kf[4][4];
#define ATT_KR(q) do { _Pragma("unroll") for (int i = 0; i < 4; ++i) kf[q][i] = *(const LAS bf16x8*)(Kc + (32 * ((q) >> 1) + r) * KPB + (16 * (4 * ((q) & 1) + i) + 8 * h) * 2); } while (0)
                ATT_KR(0); ATT_KR(1);
#pragma unroll
                for (int q = 0; q < 4; ++q) {
                    asm volatile("" : "+v"(kf[q][0]), "+v"(kf[q][1]), "+v"(kf[q][2]), "+v"(kf[q][3]));
                    if (q == 0) ATT_KR(2); if (q == 1) ATT_KR(3);
#pragma unroll
                    for (int i = 0; i < 4; ++i) st[q >> 1] = __builtin_amdgcn_mfma_f32_32x32x16_bf16(kf[q][i], qf[4 * (q & 1) + i], st[q >> 1], 0, 0, 0); }
#undef ATT_KR
            }
            const float frelb = (float)((a0 - 128 + 64 * jj + 4 * h) - (q0 + r));
            float mx = -INFINITY;
            if (jj == 0 || jj == 4) {
#pragma unroll
                for (int kt = 0; kt < 2; ++kt)
#pragma unroll
                    for (int i = 0; i < 16; ++i) { const float fr_ = frelb + (float)(32 * kt + (i & 3) + 8 * (i >> 2));
                        float t = fmaf(-slope2, fabsf(fr_), st[kt][i]); t = (fabsf(fr_) <= 128.0f) ? t : -INFINITY; st[kt][i] = t; mx = fmaxf(mx, t); }
            } else {
#pragma unroll
                for (int kt = 0; kt < 2; ++kt)
#pragma unroll
                    for (int i = 0; i < 16; ++i) { const float fr_ = frelb + (float)(32 * kt + (i & 3) + 8 * (i >> 2));
                        const float t = fmaf(-slope2, fabsf(fr_), st[kt][i]); st[kt][i] = t; mx = fmaxf(mx, t); }
            }
            mx = fmaxf(mx, __shfl_xor(mx, 32));
            const float m_new = fmaxf(m_run, mx), alpha = __builtin_amdgcn_exp2f(m_run - m_new); m_run = m_new;
            float ls = 0.f;
#pragma unroll
            for (int kt = 0; kt < 2; ++kt)
#pragma unroll
                for (int i = 0; i < 16; ++i) { const float p = __builtin_amdgcn_exp2f(st[kt][i] - m_new); st[kt][i] = p; ls += p; }
            ls += __shfl_xor(ls, 32); l_run = l_run * alpha + ls;
            if (__ballot(alpha != 1.0f) != 0ull) {
#pragma unroll
                for (int dt = 0; dt < 4; ++dt)
#pragma unroll
                    for (int i = 0; i < 16; ++i) ot[dt][i] *= alpha; }
            {
                s16x4 vlo[4][4], vhi[4][4];
#define ATT_VR(q) do { _Pragma("unroll") for (int dt = 0; dt < 4; ++dt) { const LAS unsigned char* vp = Vc + (32 * dt + r) * VPB + (32 * ((q) >> 1) + 16 * ((q) & 1) + 4 * h) * 2; \
                    vlo[q][dt] = *(const LAS s16x4*)vp; vhi[q][dt] = *(const LAS s16x4*)(vp + 16); } } while (0)
                ATT_VR(0); ATT_VR(1);
#pragma unroll
                for (int q = 0; q < 4; ++q) { const int kt = q >> 1, s = q & 1;
                    asm volatile("" : "+v"(vlo[q][0]), "+v"(vlo[q][1]), "+v"(vlo[q][2]), "+v"(vlo[q][3]), "+v"(vhi[q][0]), "+v"(vhi[q][1]), "+v"(vhi[q][2]), "+v"(vhi[q][3]));
                    if (q == 0) ATT_VR(2); if (q == 1) ATT_VR(3);
                    u32x4 pw; pw.x = cvt_pk_bf16(st[kt][8 * s + 0], st[kt][8 * s + 1]); pw.y = cvt_pk_bf16(st[kt][8 * s + 2], st[kt][8 * s + 3]); pw.z = cvt_pk_bf16(st[kt][8 * s + 4], st[kt][8 * s + 5]); pw.w = cvt_pk_bf16(st[kt][8 * s + 6], st[kt][8 * s + 7]);
                    asm volatile("s_nop 1");
                    const bf16x8 pf = __builtin_bit_cast(bf16x8, pw);
#pragma unroll
                    for (int dt = 0; dt < 4; ++dt) { const bf16x8 a2 = __builtin_shufflevector(vlo[q][dt], vhi[q][dt], 0, 1, 2, 3, 4, 5, 6, 7);
                        ot[dt] = __builtin_amdgcn_mfma_f32_32x32x16_bf16(a2, pf, ot[dt], 0, 0, 0); } }
#undef ATT_VR
            }
          }
        }
#undef ATT_LOAD
        const float inv = 1.0f / l_run;
#pragma unroll
        for (int dt = 0; dt < 4; ++dt)
#pragma unroll
            for (int g4 = 0; g4 < 4; ++g4) { u32x2 w; w.x = cvt_pk_bf16(ot[dt][4 * g4] * inv, ot[dt][4 * g4 + 1] * inv); w.y = cvt_pk_bf16(ot[dt][4 * g4 + 2] * inv, ot[dt][4 * g4 + 3] * inv);
                *(LAS u32x2*)(Ow + r * KPB + (32 * dt + 8 * g4 + 4 * h) * 2) = w; }
        asm volatile("s_waitcnt lgkmcnt(0)" ::: "memory");
#pragma unroll
        for (int it = 0; it < 8; ++it) { const int row = it * 4 + (lane >> 4), c16 = lane & 15;
            const u32x4 v = *(const LAS u32x4*)(Ow + row * KPB + c16 * 16);
            *(u32x4*)(AO + (size_t)(b * SEQ + q0 + row) * DM + hq * 128 + c16 * 8) = v; }
        asm volatile("s_waitcnt lgkmcnt(0)" ::: "memory");
    }
    __syncthreads();
}

__global__ void __launch_bounds__(512, 2) fwd(Args a) {
    extern __shared__ __attribute__((aligned(16))) unsigned char lds_raw[];
    LAS unsigned char* lds = (LAS unsigned char*)lds_raw;
    cg::grid_group grid = cg::this_grid();
    const int tid = threadIdx.x, lane = tid & 63, wid = __builtin_amdgcn_readfirstlane(tid >> 6);
    const int G = gridDim.x, bx = blockIdx.x;
    const int gw = bx * NWAVES + wid, NGW = G * NWAVES;
    unsigned char* ws = a.ws;
    volatile LAS unsigned long long* pstamp = (volatile LAS unsigned long long*)(lds + 147392);
    if (PROBE >= 0 && bx == 0 && tid == 0) pstamp[1] = 0ull;
    volatile LAS unsigned* bst = (volatile LAS unsigned*)(lds + 147424);
    if (tid < 2) bst[tid] = 0u;
    __syncthreads();
    const XcdBarrier gbar = xcd_barrier_post((unsigned*)(ws + WS_BAR), bst);
#define GRID_BAR() xcd_barrier(gbar)
    float* mod = (float*)(ws + WS_MOD);
    bf16_t* WinT = (bf16_t*)(ws + WS_WIN); bf16_t* WuT = (bf16_t*)(ws + WS_WU); bf16_t* WaT = (bf16_t*)(ws + WS_WA); bf16_t* WfT = (bf16_t*)(ws + WS_WF);
    bf16_t* WoT = (bf16_t*)(ws + WS_WO); bf16_t* WupT = (bf16_t*)(ws + WS_WUP); bf16_t* WdT = (bf16_t*)(ws + WS_WD); bf16_t* Ft = (bf16_t*)(ws + WS_FT);
    bf16_t* Hb = (bf16_t*)(ws + WS_H); bf16_t* QKV = (bf16_t*)(ws + WS_QKV); bf16_t* UT = (bf16_t*)(ws + WS_UT); bf16_t* AO = (bf16_t*)(ws + WS_AO); bf16_t* RE = (bf16_t*)(ws + WS_RE);
    bf16_t* TMP = (bf16_t*)(ws + WS_TMP); bf16_t* MERGED = (bf16_t*)(ws + WS_MERGED); bf16_t* ACT = (bf16_t*)(ws + WS_ACT);
    unsigned char* H8 = ws + WS_H8; unsigned char* Wg8 = ws + WS_WG8;
    bf16_t* HF = (bf16_t*)(ws + WS_HF); bf16_t* Vf = (bf16_t*)(ws + WS_V); float* U1024 = (float*)(ws + WS_U1024);
    bf16_t* X1B = (bf16_t*)(ws + WS_X1B);
    bf16_t* Gt = (bf16_t*)a.out;

    PH_BEGIN(0);
    {
        LAS f32x2* tab = (LAS f32x2*)(lds + 131072);
        if (tid < 256) { float s, c; sincospif((float)tid * (1.0f / 128.0f), &s, &c); tab[tid] = (f32x2){c * 0.0625f, s * 0.0625f}; }
        __syncthreads();
        for (int jb = bx; jb < NMOD / 64; jb += G) {
            const int col = jb * 64 + lane;
            LAS float* sl = (LAS float*)(lds + wid * 16384);
            float acc[NBATCH];
#pragma unroll
            for (int b = 0; b < NBATCH; ++b) acc[b] = 0.f;
            for (int half = 0; half < 2; ++half) {
                const int k0 = wid * 256 + half * 128;
                for (int i = 0; i < 40; ++i) { const int e = lane + 64 * i, kk = e & 127, bb = e >> 7;
                    const float c = (bb < 4) ? a.cp[bb * DM + k0 + kk] : a.cs[(bb - 4) * DM + k0 + kk];
                    sl[kk * NBATCH + bb] = c / (1.0f + expf(-c)); }
                asm volatile("s_waitcnt lgkmcnt(0)" ::: "memory");
#pragma unroll 8
                for (int kk = 0; kk < 128; ++kk) { const float w = a.w_mod[(size_t)(k0 + kk) * NMOD + col];
#pragma unroll
                    for (int q = 0; q < 5; ++q) { const f32x4 s = *(const LAS f32x4*)(sl + kk * NBATCH + 4 * q);
                        acc[4 * q] += s.x * w; acc[4 * q + 1] += s.y * w; acc[4 * q + 2] += s.z * w; acc[4 * q + 3] += s.w * w; } }
                asm volatile("s_waitcnt lgkmcnt(0)" ::: "memory");
            }
            LAS float* red = (LAS float*)(lds + wid * 16384 + 10240);
#pragma unroll
            for (int b = 0; b < NBATCH; ++b) red[b * 64 + lane] = acc[b];
            __syncthreads();
            for (int e = tid; e < NBATCH * 64; e += 512) { const int b = e >> 6, l = e & 63; float s = a.b_mod[jb * 64 + l];
#pragma unroll
                for (int w = 0; w < 8; ++w) s += ((const LAS float*)(lds + w * 16384 + 10240))[b * 64 + l];
                mod[(size_t)b * NMOD + jb * 64 + l] = s; }
            __syncthreads();
        }
        if (wid < 4) {
            for (int f = bx * 4 + wid; f < 1024; f += G * 4) {
                const int g = f >> 8, k0 = (f & 255) * 8;
                LAS float* wl = (LAS float*)(lds + wid * 16384);
#pragma unroll
                for (int i = 0; i < 8; ++i) { const f32x4 v = *(const f32x4*)(a.w_in + (size_t)(k0 + i) * 4096 + 3072 + g * 256 + 4 * lane);
                    wl[(4 * lane + 0) * 8 + i] = v.x; wl[(4 * lane + 1) * 8 + i] = v.y; wl[(4 * lane + 2) * 8 + i] = v.z; wl[(4 * lane + 3) * 8 + i] = v.w; }
                asm volatile("s_waitcnt lgkmcnt(0)" ::: "memory");
                float ac[4][8], as[4][8];
#pragma unroll
                for (int q = 0; q < 4; ++q)
#pragma unroll
                    for (int i = 0; i < 8; ++i) { ac[q][i] = 0.f; as[q][i] = 0.f; }
                int idx0 = 0, idx1 = 0, idx2 = 0, idx3 = 0;
                for (int d = 0; d < 256; ++d) {
                    const f32x4 w0 = *(const LAS f32x4*)(wl + d * 8), w1 = *(const LAS f32x4*)(wl + d * 8 + 4);
                    const float wv[8] = {w0.x, w0.y, w0.z, w0.w, w1.x, w1.y, w1.z, w1.w};
                    const f32x2 t0 = tab[idx0], t1 = tab[idx1], t2 = tab[idx2], t3 = tab[idx3];
                    idx0 = (idx0 + lane) & 255; idx1 = (idx1 + lane + 64) & 255; idx2 = (idx2 + lane + 128) & 255; idx3 = (idx3 + lane + 192) & 255;
#pragma unroll
                    for (int i = 0; i < 8; ++i) { ac[0][i] += wv[i] * t0.x; as[0][i] += wv[i] * t0.y; ac[1][i] += wv[i] * t1.x; as[1][i] += wv[i] * t1.y;
                        ac[2][i] += wv[i] * t2.x; as[2][i] += wv[i] * t2.y; ac[3][i] += wv[i] * t3.x; as[3][i] += wv[i] * t3.y; }
                }
#pragma unroll
                for (int q = 0; q < 4; ++q) { const int cp_ = lane + 64 * q;
                    u32x4 oc, os; oc.x = cvt_pk_bf16(ac[q][0], ac[q][1]); oc.y = cvt_pk_bf16(ac[q][2], ac[q][3]); oc.z = cvt_pk_bf16(ac[q][4], ac[q][5]); oc.w = cvt_pk_bf16(ac[q][6], ac[q][7]);
                    os.x = cvt_pk_bf16(as[q][0], as[q][1]); os.y = cvt_pk_bf16(as[q][2], as[q][3]); os.z = cvt_pk_bf16(as[q][4], as[q][5]); os.w = cvt_pk_bf16(as[q][6], as[q][7]);
                    *(u32x4*)(WuT + (size_t)(g * 256 + cp_) * DM + k0) = oc; *(u32x4*)(WuT + (size_t)(1024 + g * 256 + cp_) * DM + k0) = os; }
                asm volatile("s_waitcnt lgkmcnt(0)" ::: "memory");
            }
        }
        {
            constexpr int I1 = 32 * 96, I2 = 32 * 128, I3 = 32 * 64, I4 = 16 * 64, I5 = 32 * 64, I6 = 32 * 352, I7 = 88 * 64, I8 = 512;
            constexpr int NITEMS = I1 + I2 + I3 + I4 + I5 + I6 + I7 + I8;
            const int shard = bx & 7; unsigned* ctr = (unsigned*)(ws + WS_CTL) + 64 * shard;
            LAS float* scr = (LAS float*)(lds + wid * 16384);
            for (;;) {
                int it = 0; if (lane == 0) it = (int)atomicAdd(ctr, 1u);
                it = __builtin_amdgcn_readfirstlane(it) * 8 + shard;
                if (it >= NITEMS) break;
                int rr = it;
                if (rr < I1) { transpose_item(a.w_in, 4096, DM, WinT, 3072, 0, SrcIdent{}, scr, rr, lane); continue; } rr -= I1;
                if (rr < I2) { transpose_item_fp8(a.w_gate, 4096, DM, Wg8, 4096, 64.0f, scr, rr, lane); continue; } rr -= I2;
                if (rr < I3) { transpose_item(a.w_attn, DM, DM, WaT, DM, 0, SrcIdent{}, scr, rr, lane); continue; } rr -= I3;
                if (rr < I4) { transpose_item(a.w_four, DM, 1024, WfT, DM, 0, SrcIdent{}, scr, rr, lane); continue; } rr -= I4;
                if (rr < I5) { transpose_item(a.w_out, DM, DM, WoT, DM, 0, SrcIdent{}, scr, rr, lane); continue; } rr -= I5;
                if (rr < I6) { transpose_item(a.w_up, 2 * DFF, DM, WupT, 2 * DFF, 0, SrcUp{}, scr, rr, lane); continue; } rr -= I6;
                if (rr < I7) { transpose_item(a.w_down, DM, DFF, WdT, DM, 0, SrcIdent{}, scr, rr, lane); continue; } rr -= I7;
#pragma unroll 1
                for (int i = 0; i < 8; ++i) { const int piece = rr * 512 + lane + 64 * i, e0 = piece * 8, row = e0 >> 10, k = e0 & 1023, part = row >> 10, t = row & 1023;
                    float v[8];
#pragma unroll
                    for (int jj = 0; jj < 8; ++jj) { const int s_ = k + jj, idx = (t * s_) & 2047; float sn, cs; sincospif((float)idx * (1.0f / 1024.0f), &sn, &cs); v[jj] = (part ? -sn : cs) * 0.022097086912079608f; }
                    u32x4 o; o.x = cvt_pk_bf16(v[0], v[1]); o.y = cvt_pk_bf16(v[2], v[3]); o.z = cvt_pk_bf16(v[4], v[5]); o.w = cvt_pk_bf16(v[6], v[7]);
                    *(u32x4*)(Ft + (size_t)e0) = o; }
            }
        }
    }
    if (gridDim.y == 0x7fffu) grid.sync();
    GRID_BAR();
    PH_END(0);

    PH_BEGIN(1);
    norm_pair_rows(a.xp, a.xs, a.g_mix, mod + 0 * DM, mod + 1 * DM, Hb, HF, H8, gw, NGW, lane);
    GRID_BAR();
    PH_END(1);

    PH_BEGIN(2);
    { pg8::Order S; S.init(MTOK / 256, 12, G, bx, 0); pg8::EpiQKVG E{QKV, Gt, a.b_gate, 1.0f};
      pg8::gemm_phase<pg8::EpiQKVG, true, true>(lds, Hb, WinT, DM, S, E); }
    { pg8::Order S; S.init(MTOK / 256, 16, G, bx, 5); pg8::EpiQKVG E{QKV, Gt, a.b_gate, 0.00390625f};
      pg8::gemm_phase<pg8::EpiQKVG, false, true, true>(lds, (const bf16_t*)H8, (const bf16_t*)(Wg8 - (size_t)12 * 256 * DM), DM / 2, S, E); }
    PH_END(2); PH_BEGIN(3);
    { int lane = threadIdx.x & 63; asm volatile("" : "+v"(lane));
    for (int d = gw; d < NBATCH * 1024; d += NGW) { const int b = d >> 10, c = d & 1023;
        const u32x4* wr_ = (const u32x4*)(WuT + (size_t)c * DM); const u32x4* hr_ = (const u32x4*)(Hb + ((size_t)b * SEQ + 1024) * DM); float s = 0.f;
#pragma unroll
        for (int i = 0; i < 4; ++i) { const u32x4 w = wr_[lane + 64 * i], hv = hr_[lane + 64 * i];
            s += bf_lo(w.x) * bf_lo(hv.x) + bf_hi(w.x) * bf_hi(hv.x) + bf_lo(w.y) * bf_lo(hv.y) + bf_hi(w.y) * bf_hi(hv.y) + bf_lo(w.z) * bf_lo(hv.z) + bf_hi(w.z) * bf_hi(hv.z) + bf_lo(w.w) * bf_lo(hv.w) + bf_hi(w.w) * bf_hi(hv.w); }
        s = wave_sum(s); if (lane == 0) U1024[d] = s * 0.022097086912079608f; } }
    { pg8::Order S; S.init(NBATCH * 32, 1, G, (bx + G / 2) % G, 2); pg8::EpiBf16 E{Vf, 1024, 2};
      pg8::gemm_phase<pg8::EpiBf16, true, true>(lds, WuT, HF, DM, S, E); }
    GRID_BAR();
    PH_END(3);

    PH_BEGIN(4);
    {
        int ub = bx, ue = NBATCH * 4 * 32, us = G;
        if (G == 256) { if (bx < 64) { ub = bx * 7; ue = ub + 7; } else { ub = 448 + (bx - 64) * 11; ue = ub + 11; } us = 1; }
        attn_phase(lds, QKV, AO, a.sink, ub, ue, us);
    }
    PH_END(4); PH_BEGIN(5);
    { int lane = threadIdx.x & 63; asm volatile("" : "+v"(lane));
    for (int d = gw; d < NBATCH * 1024; d += NGW) { const u32x4* vr = (const u32x4*)(Vf + (size_t)d * 1024); float s = 0.f;
#pragma unroll
        for (int i = 0; i < 2; ++i) { const u32x4 w = vr[lane + 64 * i]; s += (bf_lo(w.x) - bf_hi(w.x)) + (bf_lo(w.y) - bf_hi(w.y)) + (bf_lo(w.z) - bf_hi(w.z)) + (bf_lo(w.w) - bf_hi(w.w)); }
        s = wave_sum(s); if (lane == 0) { const float v = s * 0.022097086912079608f + U1024[d]; RE[((size_t)(d >> 10) * SEQ + 1024) * 1024 + (d & 1023)] = (bf16_t)(cvt_pk_bf16(v, 0.f) & 0xffffu); } } }
    { pg8::Order S; S.init(NBATCH * 16, 1, G, bx, 4); pg8::EpiREsym E{RE, TMP, U1024};
      pg8::gemm_phase<pg8::EpiREsym, true, true>(lds, Ft, Vf, 1024, S, E); }
    GRID_BAR();
    PH_END(5);

    PH_BEGIN(6);
    { pg8::Order S; S.init(MTOK / 256, 8, G, bx, 0); pg8::EpiMerge<0> E{Gt, nullptr, TMP};
      pg8::gemm_phase<pg8::EpiMerge<0>, true, true>(lds, AO, WaT, DM, S, E); }
    { pg8::Order S; S.init(MTOK / 256, 8, G, bx, 0); pg8::EpiMerge<1> E{Gt, TMP, MERGED};
      pg8::gemm_phase<pg8::EpiMerge<1>, true, true>(lds, RE, WfT, 1024, S, E); }
    GRID_BAR();
    PH_END(6);

    PH_BEGIN(7);
    { pg8::Order S; S.init(MTOK / 256, 8, G, bx, 0); pg8::EpiResT<1> E{a.xp, a.xs, NPR / 256, nullptr, mod + 2 * DM, nullptr, X1B};
      pg8::gemm_phase<pg8::EpiResT<1>, true, true>(lds, MERGED, WoT, DM, S, E); }
    GRID_BAR();
    PH_END(7);

    PH_BEGIN(8);
    norm_rows_bf16src(X1B, a.g_ffn, mod + 3 * DM, mod + 4 * DM, Hb, gw, NGW, lane);
    GRID_BAR();
    PH_END(8);

    PH_BEGIN(9);
    { pg8::Order S; S.init(MTOK / 256, 44, G, bx, 0); pg8::EpiSwiGLU E{ACT};
      pg8::gemm_phase<pg8::EpiSwiGLU, true, true>(lds, Hb, WupT, DM, S, E); }
    GRID_BAR();
    PH_END(9);

    PH_BEGIN(10);
    { pg8::Order S; S.init(MTOK / 256, 8, G, bx, 0); pg8::EpiResT<2> E{nullptr, nullptr, 0, X1B, mod + 5 * DM, a.out, nullptr};
      pg8::gemm_phase<pg8::EpiResT<2>, true, true>(lds, ACT, WdT, DFF, S, E); }
    GRID_BAR();
    PH_END(10);

    PH_BEGIN(11);
    norm_rows<false, false>(a.out, a.out + (size_t)NPR * DM, a.g_final, nullptr, nullptr, a.out, gw, NGW, lane);
    PH_END(11);
    PH_BEGIN(12);
    if (PROBE >= 0 && ((PROBE >> 12) & 1)) { for (int i = 0; i < 5; ++i) GRID_BAR(); }
    PH_END(12);
    if (PROBE >= 0 && bx == 0 && tid == 0) { const unsigned long long d = pstamp[1], t2 = __builtin_amdgcn_s_memrealtime(); while (__builtin_amdgcn_s_memrealtime() - t2 < d) __builtin_amdgcn_s_sleep(8); }
}

extern "C" void kernel_launch(void* const* d_in, const int* in_sizes, int n_in, void* d_out, int out_size, void* d_ws, size_t ws_size, hipStream_t stream) {
    static int grid = 0;
    if (grid == 0) {
        if (n_in != 18 || out_size != MTOK * DM || ws_size < WS_END) { fprintf(stderr, "kernel_launch: unexpected problem (n_in %d, out %d, ws %zu < %zu)\n", n_in, out_size, ws_size, (size_t)WS_END); grid = -1; return; }
        int dev = 0, cus = 0, per_cu = 0;
        (void)hipGetDevice(&dev); (void)hipDeviceGetAttribute(&cus, hipDeviceAttributeMultiprocessorCount, dev);
        if (hipFuncSetAttribute((const void*)fwd, hipFuncAttributeMaxDynamicSharedMemorySize, LDS_BYTES) != hipSuccess) { fprintf(stderr, "kernel_launch: hipFuncSetAttribute failed\n"); grid = -1; return; }
        if (hipOccupancyMaxActiveBlocksPerMultiprocessor(&per_cu, (const void*)fwd, NWAVES * 64, LDS_BYTES) != hipSuccess || per_cu < 1) { fprintf(stderr, "kernel_launch: occupancy query says %d blocks/CU\n", per_cu); per_cu = 1; }
        (void)hipGetLastError();
        grid = cus * per_cu;
    }
    if (grid < 0) return;
    (void)hipMemsetAsync((char*)d_ws + WS_CTL, 0, CTL_BYTES, stream);
    Args a{};
    a.xp = (const float*)d_in[0]; a.xs = (const float*)d_in[1]; a.cp = (const float*)d_in[2]; a.cs = (const float*)d_in[3]; a.w_mod = (const float*)d_in[4]; a.b_mod = (const float*)d_in[5];
    a.g_mix = (const float*)d_in[6]; a.w_in = (const float*)d_in[7]; a.sink = (const float*)d_in[8]; a.w_attn = (const float*)d_in[9]; a.w_four = (const float*)d_in[10]; a.w_gate = (const float*)d_in[11];
    a.b_gate = (const float*)d_in[12]; a.w_out = (const float*)d_in[13]; a.g_ffn = (const float*)d_in[14]; a.w_up = (const float*)d_in[15]; a.w_down = (const float*)d_in[16]; a.g_final = (const float*)d_in[17];
    a.out = (float*)d_out; a.ws = (unsigned char*)d_ws;
    void* args[] = {&a};
    const hipError_t e = hipLaunchCooperativeKernel((void*)fwd, dim3(grid), dim3(NWAVES * 64), args, LDS_BYTES, stream);
    if (e != hipSuccess) fprintf(stderr, "kernel_launch: cooperative launch failed: %s (grid %d)\n", hipGetErrorString(e), grid);
}
```

```cpp
#include <hip/hip_runtime.h>
#include <hip/hip_cooperative_groups.h>
#include <cstdio>
#include <cstdint>
namespace cg = cooperative_groups;

#define LAS __attribute__((address_space(3)))
typedef unsigned short bf16_t;
typedef short bf16x8 __attribute__((ext_vector_type(8)));
typedef short s16x4 __attribute__((ext_vector_type(4)));
typedef float f32x4 __attribute__((ext_vector_type(4)));
typedef float f32x2 __attribute__((ext_vector_type(2)));
typedef float f32x16 __attribute__((ext_vector_type(16)));
typedef unsigned u32x4 __attribute__((ext_vector_type(4)));
typedef unsigned u32x2 __attribute__((ext_vector_type(2)));
typedef int i32x4 __attribute__((ext_vector_type(4)));
typedef int i32x8 __attribute__((ext_vector_type(8)));

constexpr int DM = 2048, SEQ = 2048, NBATCH = 20, MTOK = NBATCH * SEQ, NPR = 4 * SEQ;
constexpr int DFF = 5632, NMOD = 6 * DM;
constexpr float RMS_EPS = 1e-6f;
constexpr float LOG2E = 1.4426950408889634f;
constexpr size_t MiB = 1u << 20;
constexpr size_t WS_CTL = 0, WS_BAR = 4096, CTL_BYTES = 32768, WS_MOD = 32768;
constexpr size_t WS_WIN = 1 * MiB, WS_WU = 29 * MiB, WS_WA = 37 * MiB, WS_WF = 45 * MiB, WS_WO = 49 * MiB, WS_WUP = 57 * MiB, WS_WD = 101 * MiB, WS_FT = 123 * MiB;
constexpr size_t WS_H = 140 * MiB, WS_QKV = 300 * MiB, WS_UT = 540 * MiB, WS_AO = 700 * MiB, WS_RE = 860 * MiB, WS_U1024 = 940 * MiB, WS_END = 941 * MiB;
constexpr size_t WS_X1B = 740 * MiB;
constexpr size_t WS_H8 = 620 * MiB;
constexpr size_t WS_WG8 = WS_WIN + 12 * MiB;
constexpr size_t WS_HF = WS_AO, WS_V = WS_UT;
constexpr size_t WS_TMP = WS_H, WS_MERGED = WS_QKV, WS_ACT = WS_QKV;
constexpr int LDS_BYTES = 147456;
constexpr int NWAVES = 8;
#ifndef PROBE
#define PROBE -1
#endif
#define PH_BEGIN(k) do { if (PROBE >= 0 && ((PROBE >> (k)) & 1) && bx == 0 && tid == 0) pstamp[0] = __builtin_amdgcn_s_memrealtime(); } while (0)
#define PH_END(k)   do { if (PROBE >= 0 && ((PROBE >> (k)) & 1) && bx == 0 && tid == 0) pstamp[1] += __builtin_amdgcn_s_memrealtime() - pstamp[0]; } while (0)

__device__ __forceinline__ unsigned cvt_pk_bf16(float lo, float hi) { unsigned r; asm volatile("v_cvt_pk_bf16_f32 %0, %1, %2" : "=v"(r) : "v"(lo), "v"(hi)); return r; }
__device__ __forceinline__ unsigned pk_fp8x4(float a, float b, float c, float d) {
    a = fminf(fmaxf(a, -448.f), 448.f); b = fminf(fmaxf(b, -448.f), 448.f); c = fminf(fmaxf(c, -448.f), 448.f); d = fminf(fmaxf(d, -448.f), 448.f);
    int w = 0; w = __builtin_amdgcn_cvt_pk_fp8_f32(a, b, w, false); w = __builtin_amdgcn_cvt_pk_fp8_f32(c, d, w, true); return (unsigned)w; }
__device__ __forceinline__ float bf_lo(unsigned w) { return __uint_as_float(w << 16); }
__device__ __forceinline__ float bf_hi(unsigned w) { return __uint_as_float(w & 0xffff0000u); }
__device__ __forceinline__ float sigmoidf_(float v) { return __builtin_amdgcn_rcpf(1.0f + __builtin_amdgcn_exp2f(-v * LOG2E)); }
__device__ __forceinline__ float wave_sum(float v) {
#pragma unroll
    for (int o = 1; o < 64; o <<= 1) v += __shfl_xor(v, o);
    return v;
}


#define XB_TMO      128
#define XB_XCNT(j)  (256  + 64 * (j))
#define XB_XSUB(j)  (1280 + 64 * (j))
#define XB_XGEN(j)  (2304 + 64 * (j))
#define XB_TOP      3328
#define XB_TOPGEN   3392
#define XCD_BAR_WORDS 3456
#define XB_SPIN_CAP (1u << 22)
__device__ __forceinline__ unsigned xb_ld(unsigned* p)              { return __hip_atomic_load(p, __ATOMIC_RELAXED, __HIP_MEMORY_SCOPE_AGENT); }
__device__ __forceinline__ unsigned xb_add(unsigned* p, unsigned v) { return __hip_atomic_fetch_add(p, v, __ATOMIC_RELAXED, __HIP_MEMORY_SCOPE_AGENT); }
__device__ __forceinline__ unsigned xb_xcc_id() { return (unsigned)__builtin_amdgcn_s_getreg((3 << 11) | 20) & 0xFu; }
#define XB_SPIN(cond, bar) do { unsigned _sp = 0; while (cond) { __builtin_amdgcn_s_sleep(1); \
    if ((++_sp & 255u) == 0u) { if (xb_ld(&(bar)[XB_TMO])) break; if (_sp > XB_SPIN_CAP) { atomicAdd(&(bar)[XB_TMO], 1u); break; } } } } while (0)
struct XcdBarrier { unsigned* bar; unsigned x; volatile LAS unsigned* st; };
__device__ __forceinline__ XcdBarrier xcd_barrier_post(unsigned* bar, volatile LAS unsigned* st) {
    XcdBarrier b; b.bar = bar; b.x = xb_xcc_id(); b.st = st;
    if (threadIdx.x == 0) (void)xb_add(&bar[XB_XCNT(b.x)], 1u);
    return b;
}
__device__ __forceinline__ void xcd_barrier_complete(unsigned* bar, unsigned x, unsigned& nloc, unsigned& nx) {
    const unsigned G = gridDim.x * gridDim.y * gridDim.z;
    unsigned sum, cnt, mine, sp = 0u;
    for (;;) {
        sum = 0u; cnt = 0u; mine = 0u;
#pragma unroll
        for (unsigned j = 0; j < 16; ++j) { const unsigned c = xb_ld(&bar[XB_XCNT(j)]); sum += c; cnt += (c > 0u) ? 1u : 0u; mine = (j == x) ? c : mine; }
        if (sum == G) break;
        __builtin_amdgcn_s_sleep(1);
        if ((++sp & 255u) == 0u) { if (xb_ld(&bar[XB_TMO])) break; if (sp > XB_SPIN_CAP) { atomicAdd(&bar[XB_TMO], 1u); break; } }
    }
    nloc = mine > 0u ? mine : 1u; nx = cnt > 0u ? cnt : 1u;
}
__device__ __forceinline__ void xcd_barrier(const XcdBarrier& b) {
    asm volatile("s_waitcnt vmcnt(0)" ::: "memory");
    __syncthreads();
    if (threadIdx.x == 0) {
        unsigned* bar = b.bar;
        __builtin_amdgcn_s_waitcnt(0);
        unsigned nloc = b.st[0], nx = b.st[1];
        if (nloc == 0u) { xcd_barrier_complete(bar, b.x, nloc, nx); b.st[0] = nloc; b.st[1] = nx; }
        const unsigned old = xb_add(&bar[XB_XSUB(b.x)], 1u);
        const unsigned gen = old / nloc;
        if (old + 1u == (gen + 1u) * nloc) {
            __builtin_amdgcn_fence(__ATOMIC_RELEASE, "agent");
            asm volatile("s_waitcnt vmcnt(0)" ::: "memory");
            const unsigned og = xb_add(&bar[XB_TOP], 1u);
            const unsigned tg = og / nx;
            if (og + 1u == (tg + 1u) * nx) xb_add(&bar[XB_TOPGEN], 1u);
            else XB_SPIN(xb_ld(&bar[XB_TOPGEN]) == tg, bar);
            __builtin_amdgcn_fence(__ATOMIC_ACQUIRE, "agent");
            xb_add(&bar[XB_XGEN(b.x)], 1u);
            asm volatile("s_waitcnt vmcnt(0)" ::: "memory");
        } else {
            XB_SPIN(xb_ld(&bar[XB_XGEN(b.x)]) == gen, bar);
            __builtin_amdgcn_fence(__ATOMIC_ACQUIRE, "agent");
            asm volatile("s_waitcnt vmcnt(0)" ::: "memory");
        }
    }
    __syncthreads();
}

namespace pg8 {
constexpr int BM = 256, BK = 64, HALF = 128, HTB = HALF * BK * 2, STAGE_BYTES = 8 * HTB, NXCD = 8, WGM = 8;
__host__ __device__ __forceinline__ int lds_byte(int r, int c) { const int st = (r >> 4) * 2 + (c >> 5), rr = r & 15, cc = c & 31, ob = rr * 64 + cc * 2; return st * 1024 + (ob ^ (((ob >> 9) & 1) << 5)); }
__host__ __device__ __forceinline__ void stage_rc(int b, int& R, int& C) { const int st = b / 1024, sb = b % 1024, swz = sb ^ (((sb >> 9) & 1) << 5); R = (st >> 1) * 16 + swz / 64; C = (st & 1) * 32 + (swz % 64) / 2; }
__host__ __device__ __forceinline__ int perm32(int rho) { const int n = rho >> 4, i = rho & 15; return 8 * (i >> 2) + 4 * n + (i & 3); }

struct Unit { int pm, pn, ta, tb, part; };
struct Order {
    int nM, nN, nwg, G, c, dft;
    __device__ void init(int nM_, int nN_, int G_, int c_, int dft_) { nM = nM_; nN = nN_; nwg = nM * nN; G = G_; c = c_; dft = dft_; }
    __device__ bool next(int i, Unit& u) const {
        const long L = (long)((dft == 4) ? (i >> 1) : i) * G + c; if (L >= nwg) return false;
        u.part = 0;
        int wgid = (int)L; { const int q = nwg / NXCD, r = nwg % NXCD, xcd = wgid % NXCD, off = wgid / NXCD; wgid = (xcd < r ? xcd * (q + 1) : r * (q + 1) + (xcd - r) * q) + off; }
        if (dft == 2) { const int b = wgid >> 5, r = wgid & 31, half = r >> 4, jt = (r >> 2) & 3, pmi = r & 3;
            u.pm = b * 4 + pmi; u.pn = half * 4 + jt; u.ta = half * 4 + pmi; u.tb = b * 8 + half * 4 + jt; return true; }
        if (dft == 4) { const int part = i & 1, b = wgid >> 4, tm = (wgid >> 2) & 3, tn = wgid & 3;
            u.pm = b * 4 + tm; u.pn = tn; u.ta = part * 4 + tm; u.tb = part * 80 + b * 4 + tn; u.part = part; return true; }
        const int nig = WGM * nN, gid = wgid / nig, fm = gid * WGM, gsz = (nM - fm) < WGM ? (nM - fm) : WGM;
        u.pm = fm + ((wgid % nig) % gsz); u.pn = (wgid % nig) / gsz;
        if (dft == 5) { u.pn += 12; u.ta = u.pm; u.tb = u.pn; return true; }
        u.ta = dft ? (u.pm & 7) : u.pm; u.tb = dft ? ((u.pm >> 3) * 4 + u.pn) : u.pn;
        return true;
    }
};

template <class Epi, bool ALIGN_EPI, bool SP2, bool F8 = false>
__device__ __forceinline__ void gemm_phase(LAS unsigned char* lds, const bf16_t* gA, const bf16_t* gBt, const int K, const Order& S, const Epi& E) {
    int tid_ = threadIdx.x; asm volatile("" : "+v"(tid_));
    const int tid = tid_, wid = __builtin_amdgcn_readfirstlane(tid >> 6), lane = tid & 63, wr = wid >> 2, wc = wid & 3, fr = lane & 15, fq = lane >> 4;
    const int nt = K / BK;
    unsigned voffA, voffB;
    { int R, C; stage_rc(tid * 16, R, C); const int Rb = Epi::PERM ? ((R & ~31) + perm32(R & 31)) : R; voffA = (unsigned)(R * K + C) * 2u; voffB = (unsigned)(Rb * K + C) * 2u; }
    const size_t rstep = (size_t)64 * K * 2;
    const size_t kstep = (size_t)(BK * 2);
    const size_t hstep = (size_t)HALF * K * 2;
    const size_t tstep = 2 * hstep;
    const unsigned ldsw = (unsigned)wid * 1024u;
    const int aoff = lds_byte(wr * 64 + fr, fq * 8), boff = lds_byte(wc * 32 + fr, fq * 8);
#define PG8_SA(b, h) (((b) * 2 + (h)) * HTB)
#define PG8_SB(b, h) ((4 + (b) * 2 + (h)) * HTB)
#define PG8_STAGE(bufoff, gbase, voff) do { _Pragma("unroll") for (int _i = 0; _i < 2; ++_i) { unsigned _vo = (voff); asm volatile("" : "+v"(_vo));     \
        __builtin_amdgcn_global_load_lds((const unsigned*)((const char*)(gbase) + (size_t)_i * rstep + _vo), (LAS unsigned*)(lds + (bufoff) + ldsw + _i * 8192), 16, 0, 0); } } while (0)
#define PG8_LDA(dst, b, h) do { _Pragma("unroll") for (int m = 0; m < 4; ++m) dst[m] = __builtin_shufflevector(*(const LAS i32x4*)(lds + PG8_SA(b, h) + aoff + m * 2048), *(const LAS i32x4*)(lds + PG8_SA(b, h) + aoff + m * 2048 + 1024), 0, 1, 2, 3, 4, 5, 6, 7); } while (0)
#define PG8_LDB(dst, b, h) do { _Pragma("unroll") for (int n = 0; n < 2; ++n) dst[n] = __builtin_shufflevector(*(const LAS i32x4*)(lds + PG8_SB(b, h) + boff + n * 2048), *(const LAS i32x4*)(lds + PG8_SB(b, h) + boff + n * 2048 + 1024), 0, 1, 2, 3, 4, 5, 6, 7); } while (0)
#define PG8_HALF(v, k) __builtin_bit_cast(bf16x8, (k) ? __builtin_shufflevector(v, v, 4, 5, 6, 7) : __builtin_shufflevector(v, v, 0, 1, 2, 3))
#define PG8_MMA(ai, bj, At, Bt) do { __builtin_amdgcn_s_setprio(1); _Pragma("unroll") for (int m = 0; m < 4; ++m) _Pragma("unroll") for (int n = 0; n < 2; ++n) _Pragma("unroll") for (int k = 0; k < 2; ++k) \
        acc[ai][bj][m][n] = __builtin_amdgcn_mfma_f32_16x16x32_bf16(PG8_HALF(Bt[n], k), PG8_HALF(At[m], k), acc[ai][bj][m][n], 0, 0, 0); __builtin_amdgcn_s_setprio(0); } while (0)
#define PG8_MMA8(ai, bj, At, Bt) do { __builtin_amdgcn_s_setprio(1); _Pragma("unroll") for (int m = 0; m < 4; ++m) _Pragma("unroll") for (int n = 0; n < 2; ++n) \
        acc[ai][bj][m][n] = __builtin_amdgcn_mfma_scale_f32_16x16x128_f8f6f4(Bt[n], At[m], acc[ai][bj][m][n], 0, 0, 0, 0, 0, 0); __builtin_amdgcn_s_setprio(0); } while (0)
#define PG8_MM(ai, bj, At, Bt) do { if constexpr (F8) PG8_MMA8(ai, bj, At, Bt); else PG8_MMA(ai, bj, At, Bt); } while (0)
#define PG8_WAIT_V(n) asm volatile("s_waitcnt vmcnt(" #n ")" ::: "memory")
#define PG8_WAIT_L(n) asm volatile("s_waitcnt lgkmcnt(" #n ")" ::: "memory")
#define PG8_BAR __builtin_amdgcn_s_barrier()
#define PG8_SCHED __builtin_amdgcn_sched_barrier(0)
    Unit cur, nxt; int ui = 0;
    if (!S.next(0, cur)) return;
    f32x4 acc[2][2][4][2];
#pragma unroll
    for (int a = 0; a < 2; ++a)
#pragma unroll
        for (int b = 0; b < 2; ++b)
#pragma unroll
            for (int m = 0; m < 4; ++m)
#pragma unroll
                for (int n = 0; n < 2; ++n) acc[a][b][m][n] = (f32x4){0.f, 0.f, 0.f, 0.f};
    i32x8 At[4], B0[2], B1[2];
    const char* cA = (const char*)gA + (size_t)cur.ta * tstep; const char* cB = (const char*)gBt + (size_t)cur.tb * tstep;
    if constexpr (SP2) {
        PG8_STAGE(PG8_SB(0, 0), cB, voffB); PG8_STAGE(PG8_SB(0, 1), cB + hstep, voffB); PG8_STAGE(PG8_SA(0, 0), cA, voffA); PG8_STAGE(PG8_SA(0, 1), cA + hstep, voffA);
        if (wr == 1) PG8_BAR;
        PG8_WAIT_V(2); PG8_BAR;
        PG8_STAGE(PG8_SB(1, 0), cB + kstep, voffB); PG8_STAGE(PG8_SA(1, 0), cA + kstep, voffA); PG8_STAGE(PG8_SB(1, 1), cB + hstep + kstep, voffB);
        PG8_WAIT_V(6); PG8_BAR;
    } else {
        PG8_STAGE(PG8_SB(0, 0), cB, voffB); PG8_STAGE(PG8_SA(0, 0), cA, voffA); PG8_STAGE(PG8_SB(0, 1), cB + hstep, voffB); PG8_STAGE(PG8_SA(0, 1), cA + hstep, voffA);
        if (wr == 1) PG8_BAR;
        PG8_WAIT_V(4); PG8_BAR;
        PG8_STAGE(PG8_SB(1, 0), cB + kstep, voffB); PG8_STAGE(PG8_SA(1, 0), cA + kstep, voffA); PG8_STAGE(PG8_SB(1, 1), cB + hstep + kstep, voffB);
        PG8_WAIT_V(6); PG8_BAR;
    }
    for (;;) {
        const bool has_next = S.next(ui + 1, nxt);
        const char* nA = has_next ? (const char*)gA + (size_t)nxt.ta * tstep : cA; const char* nB = has_next ? (const char*)gBt + (size_t)nxt.tb * tstep : cB;
        for (int t = 0; t < nt; t += 2) {
            const bool last = (t == nt - 2);
            const char* a1 = cA + (size_t)(t + 1) * kstep;
            const char* a2 = last ? nA : cA + (size_t)(t + 2) * kstep; const char* b2 = last ? nB : cB + (size_t)(t + 2) * kstep;
            const char* a3 = a2 + kstep; const char* b3 = b2 + kstep;
            if constexpr (SP2) {
            PG8_LDB(B0, 0, 0); PG8_LDB(B1, 0, 1); PG8_SCHED; PG8_LDA(At, 0, 0); PG8_STAGE(PG8_SA(1, 1), a1 + hstep, voffA);
            PG8_WAIT_V(8); PG8_WAIT_L(0); PG8_BAR; PG8_MM(0, 0, At, B0); PG8_MM(0, 1, At, B1); PG8_BAR; PG8_SCHED;
            PG8_LDA(At, 0, 1); PG8_STAGE(PG8_SB(0, 0), b2, voffB); PG8_STAGE(PG8_SB(0, 1), b2 + hstep, voffB); PG8_STAGE(PG8_SA(0, 0), a2, voffA);
            PG8_WAIT_V(8); PG8_WAIT_L(0); PG8_BAR; PG8_MM(1, 0, At, B0); PG8_MM(1, 1, At, B1); PG8_BAR; PG8_SCHED;
            PG8_LDB(B0, 1, 0); PG8_LDB(B1, 1, 1); PG8_SCHED; PG8_LDA(At, 1, 0); PG8_STAGE(PG8_SA(0, 1), a2 + hstep, voffA);
            PG8_WAIT_V(8); PG8_WAIT_L(0); PG8_BAR; PG8_MM(0, 0, At, B0); PG8_MM(0, 1, At, B1); PG8_BAR; PG8_SCHED;
            PG8_LDA(At, 1, 1); PG8_STAGE(PG8_SB(1, 0), b3, voffB); PG8_STAGE(PG8_SB(1, 1), b3 + hstep, voffB); PG8_STAGE(PG8_SA(1, 0), a3, voffA);
            PG8_WAIT_V(8); PG8_WAIT_L(0); PG8_BAR; PG8_MM(1, 0, At, B0); PG8_MM(1, 1, At, B1); PG8_BAR; PG8_SCHED;
            } else {
            PG8_LDB(B0, 0, 0); PG8_SCHED; PG8_LDA(At, 0, 0); PG8_STAGE(PG8_SA(1, 1), a1 + hstep, voffA);
            PG8_WAIT_L(8); PG8_BAR; PG8_WAIT_L(0); PG8_MM(0, 0, At, B0); PG8_BAR; PG8_SCHED;
            PG8_LDB(B1, 0, 1); PG8_STAGE(PG8_SB(0, 0), b2, voffB);
            PG8_BAR; PG8_WAIT_L(0); PG8_MM(0, 1, At, B1); PG8_BAR;
            PG8_LDA(At, 0, 1); PG8_STAGE(PG8_SA(0, 0), a2, voffA);
            PG8_BAR; PG8_WAIT_L(0); PG8_MM(1, 0, At, B0); PG8_BAR; PG8_SCHED;
            PG8_STAGE(PG8_SB(0, 1), b2 + hstep, voffB);
            PG8_WAIT_V(6); PG8_BAR; PG8_MM(1, 1, At, B1); PG8_BAR;
            PG8_LDB(B0, 1, 0); PG8_SCHED; PG8_LDA(At, 1, 0); PG8_STAGE(PG8_SA(0, 1), a2 + hstep, voffA);
            PG8_WAIT_L(8); PG8_BAR; PG8_WAIT_L(0); PG8_MM(0, 0, At, B0); PG8_BAR; PG8_SCHED;
            PG8_LDB(B1, 1, 1); PG8_STAGE(PG8_SB(1, 0), b3, voffB);
            PG8_BAR; PG8_WAIT_L(0); PG8_MM(0, 1, At, B1); PG8_BAR;
            PG8_LDA(At, 1, 1); PG8_STAGE(PG8_SA(1, 0), a3, voffA);
            PG8_BAR; PG8_WAIT_L(0); PG8_MM(1, 0, At, B0); PG8_BAR; PG8_SCHED;
            PG8_STAGE(PG8_SB(1, 1), b3 + hstep, voffB);
            PG8_WAIT_V(6); PG8_BAR; PG8_MM(1, 1, At, B1); PG8_BAR;
            }
        }
        if constexpr (ALIGN_EPI) { if (wr == 0) PG8_BAR; }
        E(acc, cur, wr, wc, fr, fq);
        if (!has_next) break;
#pragma unroll
        for (int a = 0; a < 2; ++a)
#pragma unroll
            for (int b = 0; b < 2; ++b)
#pragma unroll
                for (int m = 0; m < 4; ++m)
#pragma unroll
                    for (int n = 0; n < 2; ++n) acc[a][b][m][n] = (f32x4){0.f, 0.f, 0.f, 0.f};
        cur = nxt; cA = nA; cB = nB; ++ui;
        if constexpr (ALIGN_EPI) { if (wr == 1) PG8_BAR; }
    }
    PG8_WAIT_V(0);
    if constexpr (!ALIGN_EPI) { if (wr == 0) PG8_BAR; }
    PG8_BAR;
#undef PG8_SA
#undef PG8_SB
#undef PG8_STAGE
#undef PG8_LDA
#undef PG8_LDB
#undef PG8_MMA
#undef PG8_HALF
#undef PG8_MMA8
#undef PG8_MM
#undef PG8_WAIT_V
#undef PG8_WAIT_L
#undef PG8_BAR
#undef PG8_SCHED
}

typedef const f32x4 (&AccRef)[2][2][4][2];
__device__ __forceinline__ u32x4 pack8(f32x4 v0, f32x4 v1) { u32x4 w; w.x = cvt_pk_bf16(v0[0], v0[1]); w.y = cvt_pk_bf16(v0[2], v0[3]); w.z = cvt_pk_bf16(v1[0], v1[1]); w.w = cvt_pk_bf16(v1[2], v1[3]); return w; }

struct EpiQKVG {
    static constexpr bool PERM = true;
    bf16_t* qkv; bf16_t* gate; const float* bgate; float gsc;
    __device__ __forceinline__ void operator()(AccRef acc, const Unit& u, int wr, int wc, int fr, int fq) const {
        const int row0 = u.pm * BM + wr * 64 + fr; const bool isg = u.pn >= 12;
        const float as = isg ? gsc : 1.0f;
        const float qs = (u.pn < 8) ? 0.08838834764831845f * LOG2E : 1.0f;
        const int col0 = (isg ? (u.pn - 12) : u.pn) * BM + wc * 32 + 8 * fq; bf16_t* base = isg ? gate : qkv; const int ldc = isg ? 4096 : 3072;
        f32x4 bv[2][2];
#pragma unroll
        for (int bj = 0; bj < 2; ++bj)
#pragma unroll
            for (int n = 0; n < 2; ++n) bv[bj][n] = isg ? *(const f32x4*)(bgate + col0 + bj * HALF + 4 * n) : (f32x4){0.f, 0.f, 0.f, 0.f};
#pragma unroll
        for (int ai = 0; ai < 2; ++ai)
#pragma unroll
            for (int m = 0; m < 4; ++m) { bf16_t* rowp = base + (size_t)(row0 + ai * HALF + m * 16) * ldc + col0;
#pragma unroll
                for (int bj = 0; bj < 2; ++bj) { f32x4 v0 = (acc[ai][bj][m][0] * as + bv[bj][0]) * qs, v1 = (acc[ai][bj][m][1] * as + bv[bj][1]) * qs;
                    if (isg) {
#pragma unroll
                        for (int j = 0; j < 4; ++j) { v0[j] = sigmoidf_(v0[j]); v1[j] = sigmoidf_(v1[j]); } }
                    *(u32x4*)(rowp + bj * HALF) = pack8(v0, v1); } }
    }
};
struct EpiGate8 {
    static constexpr bool PERM = true;
    bf16_t* gate; const float* bgate;
    __device__ __forceinline__ void operator()(AccRef acc, const Unit& u, int wr, int wc, int fr, int fq) const {
        const int row0 = u.pm * BM + wr * 64 + fr, col0 = u.pn * BM + wc * 32 + 8 * fq;
        f32x4 bv[2][2];
#pragma unroll
        for (int bj = 0; bj < 2; ++bj)
#pragma unroll
            for (int n = 0; n < 2; ++n) bv[bj][n] = *(const f32x4*)(bgate + col0 + bj * HALF + 4 * n);
#pragma unroll
        for (int ai = 0; ai < 2; ++ai)
#pragma unroll
            for (int m = 0; m < 4; ++m) { bf16_t* rowp = gate + (size_t)(row0 + ai * HALF + m * 16) * 4096 + col0;
#pragma unroll
                for (int bj = 0; bj < 2; ++bj) { f32x4 v0 = acc[ai][bj][m][0] * 0.00390625f + bv[bj][0], v1 = acc[ai][bj][m][1] * 0.00390625f + bv[bj][1];
#pragma unroll
                    for (int j = 0; j < 4; ++j) { v0[j] = sigmoidf_(v0[j]); v1[j] = sigmoidf_(v1[j]); }
                    *(u32x4*)(rowp + bj * HALF) = pack8(v0, v1); } }
    }
};
struct EpiBf16 {
    static constexpr bool PERM = true;
    bf16_t* out; int ld; int ut;
    __device__ __forceinline__ void operator()(AccRef acc, const Unit& u, int wr, int wc, int fr, int fq) const {
        size_t tb;
        if (ut == 1) { const int part = u.pm >> 2, cbase = (u.pm & 3) * 256, b = u.pn >> 3, sbase = (u.pn & 7) * 256; tb = ((size_t)(b * 1024 + cbase) * 2 + part) * 2048 + sbase; }
        else if (ut == 2) tb = (size_t)(u.pn >> 2) * ((size_t)NBATCH * 1024 * 1024) + (size_t)u.pm * BM * 1024 + (size_t)(u.pn & 3) * BM;
        else tb = (size_t)u.pm * BM * ld + (size_t)u.pn * BM;
        bf16_t* p0 = out + tb + (size_t)(wr * 64 + fr) * ld + wc * 32 + 8 * fq;
#pragma unroll
        for (int ai = 0; ai < 2; ++ai)
#pragma unroll
            for (int m = 0; m < 4; ++m) { bf16_t* rowp = p0 + (size_t)(ai * HALF + m * 16) * ld;
#pragma unroll
                for (int bj = 0; bj < 2; ++bj) *(u32x4*)(rowp + bj * HALF) = pack8(acc[ai][bj][m][0], acc[ai][bj][m][1]); }
    }
};
struct EpiRE {
    static constexpr bool PERM = true;
    bf16_t* out; const float* u1024;
    __device__ __forceinline__ void operator()(AccRef acc, const Unit& u, int wr, int wc, int fr, int fq) const {
        const int col0 = u.pn * BM + wc * 32 + 8 * fq; const float sg = (fr & 1) ? -1.0f : 1.0f;
        const float* up = u1024 + (size_t)(u.pm >> 3) * 1024 + col0;
        f32x4 uv[2][2];
#pragma unroll
        for (int bj = 0; bj < 2; ++bj)
#pragma unroll
            for (int n = 0; n < 2; ++n) uv[bj][n] = *(const f32x4*)(up + bj * HALF + 4 * n) * sg;
        bf16_t* p0 = out + ((size_t)u.pm * BM + wr * 64 + fr) * 1024 + col0;
#pragma unroll
        for (int ai = 0; ai < 2; ++ai)
#pragma unroll
            for (int m = 0; m < 4; ++m) { bf16_t* rowp = p0 + (size_t)(ai * HALF + m * 16) * 1024;
#pragma unroll
                for (int bj = 0; bj < 2; ++bj) *(u32x4*)(rowp + bj * HALF) = pack8(acc[ai][bj][m][0] + uv[bj][0], acc[ai][bj][m][1] + uv[bj][1]); }
    }
};
struct EpiREsym {
    static constexpr bool PERM = true;
    bf16_t* out; bf16_t* tmp2; const float* u1024;
    __device__ __forceinline__ void operator()(AccRef acc, const Unit& u, int wr, int wc, int fr, int fq) const {
        const int col0 = u.pn * BM + wc * 32 + 8 * fq, b = u.pm >> 2, t0 = (u.pm & 3) * BM + wr * 64 + fr;
        bf16_t* tp0 = tmp2 + ((size_t)u.pm * BM + wr * 64 + fr) * 1024 + col0;
        if (u.part == 0) {
#pragma unroll
            for (int ai = 0; ai < 2; ++ai)
#pragma unroll
                for (int m = 0; m < 4; ++m)
#pragma unroll
                    for (int bj = 0; bj < 2; ++bj) *(u32x4*)(tp0 + (size_t)(ai * HALF + m * 16) * 1024 + bj * HALF) = pack8(acc[ai][bj][m][0], acc[ai][bj][m][1]);
            return;
        }
        const float sg = (fr & 1) ? -1.0f : 1.0f; const float* up = u1024 + (size_t)b * 1024 + col0;
        f32x4 uv[2][2];
#pragma unroll
        for (int bj = 0; bj < 2; ++bj)
#pragma unroll
            for (int n = 0; n < 2; ++n) uv[bj][n] = *(const f32x4*)(up + bj * HALF + 4 * n) * sg;
#pragma unroll
        for (int ai = 0; ai < 2; ++ai)
#pragma unroll
            for (int m = 0; m < 4; ++m) { const int t = t0 + ai * HALF + m * 16;
                bf16_t* lo = out + ((size_t)b * SEQ + t) * 1024 + col0; bf16_t* hi = out + ((size_t)b * SEQ + (SEQ - t)) * 1024 + col0;
#pragma unroll
                for (int bj = 0; bj < 2; ++bj) { const u32x4 pw = *(const u32x4*)(tp0 + (size_t)(ai * HALF + m * 16) * 1024 + bj * HALF);
                    const f32x4 p0 = (f32x4){bf_lo(pw.x), bf_hi(pw.x), bf_lo(pw.y), bf_hi(pw.y)} + uv[bj][0], p1 = (f32x4){bf_lo(pw.z), bf_hi(pw.z), bf_lo(pw.w), bf_hi(pw.w)} + uv[bj][1];
                    *(u32x4*)(lo + bj * HALF) = pack8(p0 + acc[ai][bj][m][0], p1 + acc[ai][bj][m][1]);
                    if (t != 0) *(u32x4*)(hi + bj * HALF) = pack8(p0 - acc[ai][bj][m][0], p1 - acc[ai][bj][m][1]); } }
    }
};
template <int PART> struct EpiMerge {
    static constexpr bool PERM = true;
    const bf16_t* G; const bf16_t* tmp_in; bf16_t* out;
    __device__ __forceinline__ void operator()(AccRef acc, const Unit& u, int wr, int wc, int fr, int fq) const {
        const int row0 = u.pm * BM + wr * 64 + fr, col0 = u.pn * BM + wc * 32 + 8 * fq;
#pragma unroll
        for (int ai = 0; ai < 2; ++ai)
#pragma unroll
            for (int m = 0; m < 4; ++m) { const size_t row = (size_t)(row0 + ai * HALF + m * 16);
#pragma unroll
                for (int bj = 0; bj < 2; ++bj) { const int col = col0 + bj * HALF;
                    const u32x4 g = *(const u32x4*)(G + row * 4096 + PART * 2048 + col);
                    f32x4 v0 = acc[ai][bj][m][0], v1 = acc[ai][bj][m][1];
                    v0[0] *= bf_lo(g.x); v0[1] *= bf_hi(g.x); v0[2] *= bf_lo(g.y); v0[3] *= bf_hi(g.y); v1[0] *= bf_lo(g.z); v1[1] *= bf_hi(g.z); v1[2] *= bf_lo(g.w); v1[3] *= bf_hi(g.w);
                    if (PART == 1) { const u32x4 t = *(const u32x4*)(tmp_in + row * 2048 + col);
                        v0[0] += bf_lo(t.x); v0[1] += bf_hi(t.x); v0[2] += bf_lo(t.y); v0[3] += bf_hi(t.y); v1[0] += bf_lo(t.z); v1[1] += bf_hi(t.z); v1[2] += bf_lo(t.w); v1[3] += bf_hi(t.w); }
                    *(u32x4*)(out + row * 2048 + col) = pack8(v0, v1); } }
    }
};
struct EpiRes {
    static constexpr bool PERM = false;
    const float* base0; const float* base1; int split; const float* gate; float* out;
    __device__ __forceinline__ void operator()(AccRef acc, const Unit& u, int wr, int wc, int fr, int fq) const {
        const int rl0 = wr * 64 + fr, col0 = u.pn * BM + wc * 32 + 4 * fq;
        const float* bp = (u.pm < split) ? base0 + (size_t)u.pm * BM * DM : base1 + (size_t)(u.pm - split) * BM * DM;
        float* op = out + (size_t)u.pm * BM * DM; const float* gp = gate + (size_t)(u.pm >> 3) * NMOD + col0;
        f32x4 gv[2][2];
#pragma unroll
        for (int bj = 0; bj < 2; ++bj)
#pragma unroll
            for (int n = 0; n < 2; ++n) gv[bj][n] = *(const f32x4*)(gp + bj * HALF + n * 16);
#pragma unroll
        for (int aim = 0; aim < 4; ++aim) {
            const int ai = aim >> 1, mb = (aim & 1) * 2;
            f32x4 bs[2][2][2];
#pragma unroll
            for (int m = 0; m < 2; ++m) { const size_t off = (size_t)(rl0 + ai * HALF + (mb + m) * 16) * DM + col0;
#pragma unroll
                for (int bj = 0; bj < 2; ++bj)
#pragma unroll
                    for (int n = 0; n < 2; ++n) bs[m][bj][n] = *(const f32x4*)(bp + off + bj * HALF + n * 16); }
#pragma unroll
            for (int m = 0; m < 2; ++m) { const size_t off = (size_t)(rl0 + ai * HALF + (mb + m) * 16) * DM + col0;
#pragma unroll
                for (int bj = 0; bj < 2; ++bj)
#pragma unroll
                    for (int n = 0; n < 2; ++n) *(f32x4*)(op + off + bj * HALF + n * 16) = bs[m][bj][n] + gv[bj][n] * acc[ai][bj][mb + m][n]; }
            asm volatile("" ::: "memory"); }
    }
};
template <int MODE> struct EpiResT {
    static constexpr bool PERM = true;
    const float* base0; const float* base1; int split; const bf16_t* base16; const float* gate; float* out32; bf16_t* out16;
    __device__ __forceinline__ void operator()(AccRef acc, const Unit& u, int wr, int wc, int fr, int fq) const {
        const int rl0 = wr * 64 + fr, col0 = u.pn * BM + wc * 32 + 8 * fq;
        const float* gp = gate + (size_t)(u.pm >> 3) * NMOD + col0;
        f32x4 gv[2][2];
#pragma unroll
        for (int bj = 0; bj < 2; ++bj)
#pragma unroll
            for (int n = 0; n < 2; ++n) gv[bj][n] = *(const f32x4*)(gp + bj * HALF + 4 * n);
        if constexpr (MODE == 1) {
            const float* bp = (u.pm < split) ? base0 + (size_t)u.pm * BM * DM : base1 + (size_t)(u.pm - split) * BM * DM;
            bf16_t* op = out16 + (size_t)u.pm * BM * DM;
#pragma unroll
            for (int aim = 0; aim < 4; ++aim) {
                const int ai = aim >> 1, mb = (aim & 1) * 2;
                f32x4 bs[2][2][2];
#pragma unroll
                for (int m = 0; m < 2; ++m) { const size_t off = (size_t)(rl0 + ai * HALF + (mb + m) * 16) * DM + col0;
#pragma unroll
                    for (int bj = 0; bj < 2; ++bj)
#pragma unroll
                        for (int n = 0; n < 2; ++n) bs[m][bj][n] = *(const f32x4*)(bp + off + bj * HALF + 4 * n); }
#pragma unroll
                for (int m = 0; m < 2; ++m) { const size_t off = (size_t)(rl0 + ai * HALF + (mb + m) * 16) * DM + col0;
#pragma unroll
                    for (int bj = 0; bj < 2; ++bj) *(u32x4*)(op + off + bj * HALF) = pack8(bs[m][bj][0] + gv[bj][0] * acc[ai][bj][mb + m][0], bs[m][bj][1] + gv[bj][1] * acc[ai][bj][mb + m][1]); }
                asm volatile("" ::: "memory"); }
        } else {
            const bf16_t* bp = base16 + (size_t)u.pm * BM * DM; float* op = out32 + (size_t)u.pm * BM * DM;
#pragma unroll
            for (int ai = 0; ai < 2; ++ai) {
                u32x4 t[4][2];
#pragma unroll
                for (int m = 0; m < 4; ++m) { const size_t off = (size_t)(rl0 + ai * HALF + m * 16) * DM + col0;
#pragma unroll
                    for (int bj = 0; bj < 2; ++bj) t[m][bj] = *(const u32x4*)(bp + off + bj * HALF); }
#pragma unroll
                for (int m = 0; m < 4; ++m) { const size_t off = (size_t)(rl0 + ai * HALF + m * 16) * DM + col0;
#pragma unroll
                    for (int bj = 0; bj < 2; ++bj) { const u32x4 w = t[m][bj];
                        *(f32x4*)(op + off + bj * HALF) = (f32x4){bf_lo(w.x), bf_hi(w.x), bf_lo(w.y), bf_hi(w.y)} + gv[bj][0] * acc[ai][bj][m][0];
                        *(f32x4*)(op + off + bj * HALF + 4) = (f32x4){bf_lo(w.z), bf_hi(w.z), bf_lo(w.w), bf_hi(w.w)} + gv[bj][1] * acc[ai][bj][m][1]; } }
                asm volatile("" ::: "memory"); }
        }
    }
};
struct EpiSwiGLU {
    static constexpr bool PERM = false;
    bf16_t* act;
    __device__ __forceinline__ void operator()(AccRef acc, const Unit& u, int wr, int wc, int fr, int fq) const {
        bf16_t* p0 = act + (size_t)(u.pm * BM + wr * 64 + fr) * DFF + u.pn * 128 + wc * 32 + 8 * fq;
#pragma unroll
        for (int ai = 0; ai < 2; ++ai)
#pragma unroll
            for (int m = 0; m < 4; ++m) { f32x4 o[2];
#pragma unroll
                for (int bj = 0; bj < 2; ++bj)
#pragma unroll
                    for (int j = 0; j < 4; ++j) { const float g = acc[ai][bj][m][0][j]; o[bj][j] = g * sigmoidf_(g) * acc[ai][bj][m][1][j]; }
                *(u32x4*)(p0 + (size_t)(ai * HALF + m * 16) * DFF) = pack8(o[0], o[1]); }
    }
};
}

struct Args {
    const float *xp, *xs, *cp, *cs, *w_mod, *b_mod, *g_mix, *w_in, *sink, *w_attn, *w_four, *w_gate, *b_gate, *w_out, *g_ffn, *w_up, *w_down, *g_final;
    float* out; unsigned char* ws;
};

struct SrcIdent { __device__ __forceinline__ int operator()(int R) const { return R; } };
struct SrcUp { __device__ __forceinline__ int operator()(int R) const {
    const int pn = R >> 8, r = R & 255, bj = r >> 7, wc = (r >> 5) & 3, n = (r >> 4) & 1, i = r & 15, fq = i >> 2, j = i & 3;
    return (n ? DFF : 0) + 128 * pn + 32 * wc + 8 * fq + 4 * bj + j; } };
template <class Src> __device__ __forceinline__ void transpose_item(const float* W, int ldw, int K, bf16_t* WT, int nrows, int row_off, const Src src, LAS float* scr, int item, int lane) {
    const int nblk = nrows / 32, kb = item / nblk, nb = item % nblk, k0 = 64 * kb, n0 = 32 * nb;
    const int sc = src(n0 + (lane & 31));
#pragma unroll 8
    for (int i = 0; i < 32; ++i) { const int kk = 2 * i + (lane >> 5); scr[kk * 33 + (lane & 31)] = W[(size_t)(k0 + kk) * ldw + sc]; }
    asm volatile("s_waitcnt lgkmcnt(0)" ::: "memory");
    const int c = lane & 7;
#pragma unroll
    for (int j = 0; j < 4; ++j) { const int n = (lane >> 3) + 8 * j; const LAS float* s = scr + (8 * c) * 33 + n;
        u32x4 o; o.x = cvt_pk_bf16(s[0 * 33], s[1 * 33]); o.y = cvt_pk_bf16(s[2 * 33], s[3 * 33]); o.z = cvt_pk_bf16(s[4 * 33], s[5 * 33]); o.w = cvt_pk_bf16(s[6 * 33], s[7 * 33]);
        *(u32x4*)(WT + (size_t)(row_off + n0 + n) * K + k0 + 8 * c) = o; }
    asm volatile("s_waitcnt lgkmcnt(0)" ::: "memory");
}

__device__ __forceinline__ void transpose_item_fp8(const float* W, int ldw, int K, unsigned char* WT, int nrows, float scale, LAS float* scr, int item, int lane) {
    const int nblk = nrows / 32, kb = item / nblk, nb = item % nblk, k0 = 64 * kb, n0 = 32 * nb;
#pragma unroll 8
    for (int i = 0; i < 32; ++i) { const int kk = 2 * i + (lane >> 5); scr[kk * 33 + (lane & 31)] = W[(size_t)(k0 + kk) * ldw + n0 + (lane & 31)]; }
    asm volatile("s_waitcnt lgkmcnt(0)" ::: "memory");
    const int c = lane & 3;
#pragma unroll
    for (int q = 0; q < 2; ++q) { const int n = (lane >> 2) + 16 * q; const LAS float* s = scr + (16 * c) * 33 + n;
        u32x4 o; o.x = pk_fp8x4(s[0 * 33] * scale, s[1 * 33] * scale, s[2 * 33] * scale, s[3 * 33] * scale); o.y = pk_fp8x4(s[4 * 33] * scale, s[5 * 33] * scale, s[6 * 33] * scale, s[7 * 33] * scale);
        o.z = pk_fp8x4(s[8 * 33] * scale, s[9 * 33] * scale, s[10 * 33] * scale, s[11 * 33] * scale); o.w = pk_fp8x4(s[12 * 33] * scale, s[13 * 33] * scale, s[14 * 33] * scale, s[15 * 33] * scale);
        *(u32x4*)(WT + (size_t)(n0 + n) * K + k0 + 16 * c) = o; }
    asm volatile("s_waitcnt lgkmcnt(0)" ::: "memory");
}

template <bool OUT_BF16, bool HAS_MOD>
__device__ __forceinline__ void norm_rows(const float* src0, const float* src1, const float* g, const float* mod_shift, const float* mod_scale, void* outp, int gw, int NGW, int lane) {
    asm volatile("" : "+v"(lane));
    for (int m0 = gw; m0 < MTOK; m0 += 2 * NGW) {
        const int m1 = m0 + NGW; const bool has1 = m1 < MTOK; const int m1c = has1 ? m1 : m0;
        const float* xr0 = (m0 < NPR) ? src0 + (size_t)m0 * DM : src1 + (size_t)(m0 - NPR) * DM;
        const float* xr1 = (m1c < NPR) ? src0 + (size_t)m1c * DM : src1 + (size_t)(m1c - NPR) * DM;
        f32x4 v0[8], v1[8]; float s0 = 0.f, s1 = 0.f;
#pragma unroll
        for (int j = 0; j < 8; ++j) { v0[j] = __builtin_nontemporal_load((const f32x4*)xr0 + lane + 64 * j); v1[j] = __builtin_nontemporal_load((const f32x4*)xr1 + lane + 64 * j); }
#pragma unroll
        for (int j = 0; j < 8; ++j) { s0 += (v0[j].x * v0[j].x + v0[j].y * v0[j].y) + (v0[j].z * v0[j].z + v0[j].w * v0[j].w); s1 += (v1[j].x * v1[j].x + v1[j].y * v1[j].y) + (v1[j].z * v1[j].z + v1[j].w * v1[j].w); }
#pragma unroll
        for (int o = 1; o < 64; o <<= 1) { s0 += __shfl_xor(s0, o); s1 += __shfl_xor(s1, o); }
        const float r0 = 1.0f / sqrtf(s0 * (1.0f / DM) + RMS_EPS), r1 = 1.0f / sqrtf(s1 * (1.0f / DM) + RMS_EPS);
        const int b0 = m0 >> 11, b1 = m1c >> 11;
#pragma unroll
        for (int j = 0; j < 8; ++j) { const int col = 4 * lane + 256 * j; const f32x4 gg = *(const f32x4*)(g + col);
            f32x4 y0 = v0[j] * r0 * gg, y1 = v1[j] * r1 * gg;
            if (HAS_MOD) { const f32x4 sc0 = *(const f32x4*)(mod_scale + (size_t)b0 * NMOD + col), sh0 = *(const f32x4*)(mod_shift + (size_t)b0 * NMOD + col); y0 = y0 * (1.0f + sc0) + sh0;
                           const f32x4 sc1 = *(const f32x4*)(mod_scale + (size_t)b1 * NMOD + col), sh1 = *(const f32x4*)(mod_shift + (size_t)b1 * NMOD + col); y1 = y1 * (1.0f + sc1) + sh1; }
            if (OUT_BF16) { u32x2 w; w.x = cvt_pk_bf16(y0.x, y0.y); w.y = cvt_pk_bf16(y0.z, y0.w); *(u32x2*)((bf16_t*)outp + (size_t)m0 * DM + col) = w;
                            if (has1) { u32x2 w1; w1.x = cvt_pk_bf16(y1.x, y1.y); w1.y = cvt_pk_bf16(y1.z, y1.w); *(u32x2*)((bf16_t*)outp + (size_t)m1 * DM + col) = w1; } }
            else { __builtin_nontemporal_store(y0, (f32x4*)((float*)outp + (size_t)m0 * DM + col)); if (has1) __builtin_nontemporal_store(y1, (f32x4*)((float*)outp + (size_t)m1 * DM + col)); } }
    }
}


__device__ __forceinline__ void norm_pair_rows(const float* src0, const float* src1, const float* g, const float* mod_shift, const float* mod_scale, bf16_t* Hout, bf16_t* HF, unsigned char* H8, int gw, int NGW, int lane) {
    asm volatile("" : "+v"(lane));
    for (int it = gw; it < NBATCH * 1025; it += NGW) {
        const int b = it / 1025, s = it - b * 1025, p = (2048 - s) & 2047;
        const int m0 = b * SEQ + s, m1 = b * SEQ + p;
        const float* xr0 = (m0 < NPR) ? src0 + (size_t)m0 * DM : src1 + (size_t)(m0 - NPR) * DM;
        const float* xr1 = (m1 < NPR) ? src0 + (size_t)m1 * DM : src1 + (size_t)(m1 - NPR) * DM;
        f32x4 v0[8], v1[8]; float s0 = 0.f, s1 = 0.f;
#pragma unroll
        for (int j = 0; j < 8; ++j) { v0[j] = __builtin_nontemporal_load((const f32x4*)xr0 + lane + 64 * j); v1[j] = __builtin_nontemporal_load((const f32x4*)xr1 + lane + 64 * j); }
#pragma unroll
        for (int j = 0; j < 8; ++j) { s0 += (v0[j].x * v0[j].x + v0[j].y * v0[j].y) + (v0[j].z * v0[j].z + v0[j].w * v0[j].w); s1 += (v1[j].x * v1[j].x + v1[j].y * v1[j].y) + (v1[j].z * v1[j].z + v1[j].w * v1[j].w); }
#pragma unroll
        for (int o = 1; o < 64; o <<= 1) { s0 += __shfl_xor(s0, o); s1 += __shfl_xor(s1, o); }
        const float r0 = 1.0f / sqrtf(s0 * (1.0f / DM) + RMS_EPS), r1 = 1.0f / sqrtf(s1 * (1.0f / DM) + RMS_EPS);
        const bool pair = (p != s), fold = (s < 1024);
#pragma unroll
        for (int j = 0; j < 8; ++j) { const int col = 4 * lane + 256 * j; const f32x4 gg = *(const f32x4*)(g + col);
            const f32x4 sc = *(const f32x4*)(mod_scale + (size_t)b * NMOD + col), sh = *(const f32x4*)(mod_shift + (size_t)b * NMOD + col);
            const f32x4 y0 = v0[j] * r0 * gg * (1.0f + sc) + sh, y1 = v1[j] * r1 * gg * (1.0f + sc) + sh;
            u32x2 w; w.x = cvt_pk_bf16(y0.x, y0.y); w.y = cvt_pk_bf16(y0.z, y0.w); *(u32x2*)(Hout + (size_t)m0 * DM + col) = w;
            *(unsigned*)(H8 + (size_t)m0 * DM + col) = pk_fp8x4(y0.x * 4.0f, y0.y * 4.0f, y0.z * 4.0f, y0.w * 4.0f);
            if (pair) { u32x2 w1; w1.x = cvt_pk_bf16(y1.x, y1.y); w1.y = cvt_pk_bf16(y1.z, y1.w); *(u32x2*)(Hout + (size_t)m1 * DM + col) = w1;
                        *(unsigned*)(H8 + (size_t)m1 * DM + col) = pk_fp8x4(y1.x * 4.0f, y1.y * 4.0f, y1.z * 4.0f, y1.w * 4.0f); }
            if (fold) { const f32x4 pl = pair ? (y0 + y1) : y0, mi = y0 - y1;
                u32x2 wp, wm; wp.x = cvt_pk_bf16(pl.x, pl.y); wp.y = cvt_pk_bf16(pl.z, pl.w); wm.x = cvt_pk_bf16(mi.x, mi.y); wm.y = cvt_pk_bf16(mi.z, mi.w);
                *(u32x2*)(HF + ((size_t)b * SEQ + s) * DM + col) = wp; *(u32x2*)(HF + ((size_t)b * SEQ + 1024 + s) * DM + col) = wm; } }
    }
}


__device__ __forceinline__ void norm_rows_bf16src(const bf16_t* src, const float* g, const float* mod_shift, const float* mod_scale, bf16_t* outp, int gw, int NGW, int lane) {
    asm volatile("" : "+v"(lane));
    for (int m0 = gw; m0 < MTOK; m0 += 2 * NGW) {
        const int m1 = m0 + NGW; const bool has1 = m1 < MTOK; const int m1c = has1 ? m1 : m0;
        const u32x4* p0 = (const u32x4*)(src + (size_t)m0 * DM); const u32x4* p1 = (const u32x4*)(src + (size_t)m1c * DM);
        u32x4 w0[4], w1[4]; float s0 = 0.f, s1 = 0.f;
#pragma unroll
        for (int j = 0; j < 4; ++j) { w0[j] = __builtin_nontemporal_load(p0 + lane + 64 * j); w1[j] = __builtin_nontemporal_load(p1 + lane + 64 * j); }
#pragma unroll
        for (int j = 0; j < 4; ++j)
#pragma unroll
            for (int e = 0; e < 4; ++e) { const float a0 = bf_lo(w0[j][e]), b0 = bf_hi(w0[j][e]), a1 = bf_lo(w1[j][e]), b1 = bf_hi(w1[j][e]); s0 += a0 * a0 + b0 * b0; s1 += a1 * a1 + b1 * b1; }
#pragma unroll
        for (int o = 1; o < 64; o <<= 1) { s0 += __shfl_xor(s0, o); s1 += __shfl_xor(s1, o); }
        const float r0 = 1.0f / sqrtf(s0 * (1.0f / DM) + RMS_EPS), r1 = 1.0f / sqrtf(s1 * (1.0f / DM) + RMS_EPS);
        const int b0i = m0 >> 11, b1i = m1c >> 11;
#pragma unroll
        for (int j = 0; j < 4; ++j) { const int col = 8 * lane + 512 * j; f32x4 y0[2], y1[2];
#pragma unroll
            for (int hh = 0; hh < 2; ++hh) { const int c4 = col + 4 * hh; const f32x4 gg = *(const f32x4*)(g + c4);
                const f32x4 sc0 = *(const f32x4*)(mod_scale + (size_t)b0i * NMOD + c4), sh0 = *(const f32x4*)(mod_shift + (size_t)b0i * NMOD + c4);
                const f32x4 sc1 = *(const f32x4*)(mod_scale + (size_t)b1i * NMOD + c4), sh1 = *(const f32x4*)(mod_shift + (size_t)b1i * NMOD + c4);
                const f32x4 x0 = (f32x4){bf_lo(w0[j][2 * hh]), bf_hi(w0[j][2 * hh]), bf_lo(w0[j][2 * hh + 1]), bf_hi(w0[j][2 * hh + 1])};
                const f32x4 x1 = (f32x4){bf_lo(w1[j][2 * hh]), bf_hi(w1[j][2 * hh]), bf_lo(w1[j][2 * hh + 1]), bf_hi(w1[j][2 * hh + 1])};
                y0[hh] = x0 * r0 * gg * (1.0f + sc0) + sh0; y1[hh] = x1 * r1 * gg * (1.0f + sc1) + sh1; }
            *(u32x4*)(outp + (size_t)m0 * DM + col) = pg8::pack8(y0[0], y0[1]);
            if (has1) *(u32x4*)(outp + (size_t)m1 * DM + col) = pg8::pack8(y1[0], y1[1]); }
    }
}

__device__ __forceinline__ void attn_phase(LAS unsigned char* lds, const bf16_t* QKV, bf16_t* AO, const float* sink, int ubeg, int uend, int ustep) {
    int tid_ = threadIdx.x; asm volatile("" : "+v"(tid_));
    const int tid = tid_, lane = tid & 63, wid = __builtin_amdgcn_readfirstlane(tid >> 6);
    const int r = lane & 31, h = lane >> 5, hg = wid >> 1, w2 = wid & 1;
    constexpr int KPB = 272, VPB = 136, CHB = 17408;
    LAS unsigned char* Kb = lds; LAS unsigned char* Vb = lds + 2 * CHB; LAS unsigned char* Ow = lds + 4 * CHB + wid * (32 * KPB);
    int cc = 0;
    bf16x8 qf[8]; u32x4 kreg[1][2], vreg[1][2];
    const int kp = tid & 31, dg = tid >> 5;
#define ATT_QLOAD(b_, q0_, hq_) do { const bf16_t* qrow_ = QKV + (size_t)((b_) * SEQ + (q0_) + r) * 3072 + (hq_) * 128 + 8 * h; \
        _Pragma("unroll") for (int ks = 0; ks < 8; ++ks) qf[ks] = *(const bf16x8*)(qrow_ + 16 * ks); } while (0)
#define ATT_LOAD_T(tokb_, kvh_) do { const size_t tokb = (size_t)(tokb_); \
        _Pragma("unroll") for (int i = 0; i < 2; ++i) { const int p = tid + 512 * i; kreg[0][i] = *(const u32x4*)(QKV + (tokb + (p >> 4)) * 3072 + 2048 + (kvh_) * 128 + (p & 15) * 8); } \
        _Pragma("unroll") for (int i = 0; i < 2; ++i) vreg[0][i] = *(const u32x4*)(QKV + (tokb + 2 * kp + i) * 3072 + 2560 + (kvh_) * 128 + dg * 8); } while (0)
    if (ubeg < uend) { const int b = ubeg >> 7, kvh = (ubeg >> 5) & 3, qb = ubeg & 31, jl = (2 - qb) > 0 ? (2 - qb) : 0;
        ATT_QLOAD(b, qb * 64 + 32 * w2, kvh * 4 + hg); ATT_LOAD_T(b * SEQ + qb * 64 - 128 + 64 * jl, kvh); }
    for (int u = ubeg; u < uend; u += ustep) {
        const int b = u >> 7, kvh = (u >> 5) & 3, qb = u & 31, a0 = qb * 64, q0 = a0 + 32 * w2, hq = kvh * 4 + hg;
        const float slope2 = exp2f(-0.5f * (float)(hq + 1)) * LOG2E, sink2 = sink[hq] * LOG2E;
        const int un = u + ustep; const bool has_next = un < uend;
        const int bn = un >> 7, kvhn = (un >> 5) & 3, qbn = un & 31, jln = (2 - qbn) > 0 ? (2 - qbn) : 0;
        f32x16 ot[4];
#pragma unroll
        for (int dt = 0; dt < 4; ++dt)
#pragma unroll
            for (int i = 0; i < 16; ++i) ot[dt][i] = 0.f;
        float m_run = sink2, l_run = 1.0f;
        const int jlo = (2 - qb) > 0 ? (2 - qb) : 0, jhi = (33 - qb) < 4 ? (33 - qb) : 4;
        for (int j = jlo; j <= jhi; j += 2) {
#pragma unroll
          for (int sub = 0; sub < 2; ++sub) {
            const int jj = j + sub; if (jj > jhi) break;
            LAS unsigned char* Kc = Kb + (cc & 1) * CHB; LAS unsigned char* Vc = Vb + (cc & 1) * CHB; ++cc;
#pragma unroll
            for (int i = 0; i < 2; ++i) { const int p = tid + 512 * i; *(LAS u32x4*)(Kc + (p >> 4) * KPB + (p & 15) * 16) = kreg[0][i]; }
#pragma unroll
            for (int w = 0; w < 4; ++w) { const unsigned x0 = vreg[0][0][w], x1 = vreg[0][1][w];
                *(LAS unsigned*)(Vc + (8 * dg + 2 * w) * VPB + kp * 4) = (x0 & 0xffffu) | (x1 << 16);
                *(LAS unsigned*)(Vc + (8 * dg + 2 * w + 1) * VPB + kp * 4) = (x0 >> 16) | (x1 & 0xffff0000u); }
            __syncthreads();
            if (jj + 1 <= jhi) ATT_LOAD_T(b * SEQ + a0 - 128 + 64 * (jj + 1), kvh);
            else if (has_next) ATT_LOAD_T(bn * SEQ + qbn * 64 - 128 + 64 * jln, kvhn);
            f32x16 st[2];
#pragma unroll
            for (int kt = 0; kt < 2; ++kt)
#pragma unroll
                for (int i = 0; i < 16; ++i) st[kt][i] = 0.f;
            {
                bf16x8 kf[4][4];
#define ATT_KR(q) do { _Pragma("unroll") for (int i = 0; i < 4; ++i) kf[q][i] = *(const LAS bf16x8*)(Kc + (32 * ((q) >> 1) + r) * KPB + (16 * (4 * ((q) & 1) + i) + 8 * h) * 2); } while (0)
                ATT_KR(0);
#pragma unroll
                for (int q = 0; q < 4; ++q) {
                    asm volatile("" : "+v"(kf[q][0]), "+v"(kf[q][1]), "+v"(kf[q][2]), "+v"(kf[q][3]));
                    if (q < 3) { if (q == 0) ATT_KR(1); if (q == 1) ATT_KR(2); if (q == 2) ATT_KR(3); }
#pragma unroll
                    for (int i = 0; i < 4; ++i) st[q >> 1] = __builtin_amdgcn_mfma_f32_32x32x16_bf16(kf[q][i], qf[4 * (q & 1) + i], st[q >> 1], 0, 0, 0); }
#undef ATT_KR
            }
            if (jj == jhi && has_next) ATT_QLOAD(bn, qbn * 64 + 32 * w2, kvhn * 4 + hg);
            const float frelb = (float)((a0 - 128 + 64 * jj + 4 * h) - (q0 + r));
            float mx = -INFINITY;
            if (jj == 0 || jj == 4) {
#pragma unroll
                for (int kt = 0; kt < 2; ++kt)
#pragma unroll
                    for (int i = 0; i < 16; ++i) { const float fr_ = frelb + (float)(32 * kt + (i & 3) + 8 * (i >> 2));
                        float t = fmaf(-slope2, fabsf(fr_), st[kt][i]); t = (fabsf(fr_) <= 128.0f) ? t : -INFINITY; st[kt][i] = t; mx = fmaxf(mx, t); }
            } else {
#pragma unroll
                for (int kt = 0; kt < 2; ++kt)
#pragma unroll
                    for (int i = 0; i < 16; ++i) { const float fr_ = frelb + (float)(32 * kt + (i & 3) + 8 * (i >> 2));
                        const float t = fmaf(-slope2, fabsf(fr_), st[kt][i]); st[kt][i] = t; mx = fmaxf(mx, t); }
            }
            mx = fmaxf(mx, __shfl_xor(mx, 32));
            const float m_new = fmaxf(m_run, mx), alpha = __builtin_amdgcn_exp2f(m_run - m_new); m_run = m_new;
            float ls = 0.f;
#pragma unroll
            for (int kt = 0; kt < 2; ++kt)
#pragma unroll
                for (int i = 0; i < 16; ++i) { const float p = __builtin_amdgcn_exp2f(st[kt][i] - m_new); st[kt][i] = p; ls += p; }
            ls += __shfl_xor(ls, 32); l_run = l_run * alpha + ls;
            if (__ballot(alpha != 1.0f) != 0ull) {
#pragma unroll
                for (int dt = 0; dt < 4; ++dt)
#pragma unroll
                    for (int i = 0; i < 16; ++i) ot[dt][i] *= alpha; }
            {
                s16x4 vlo[4][4], vhi[4][4];
#define ATT_VR(q) do { _Pragma("unroll") for (int dt = 0; dt < 4; ++dt) { const LAS unsigned char* vp = Vc + (32 * dt + r) * VPB + (32 * ((q) >> 1) + 16 * ((q) & 1) + 4 * h) * 2; \
                    vlo[q][dt] = *(const LAS s16x4*)vp; vhi[q][dt] = *(const LAS s16x4*)(vp + 16); } } while (0)
                ATT_VR(0);
#pragma unroll
                for (int q = 0; q < 4; ++q) { const int kt = q >> 1, s = q & 1;
                    asm volatile("" : "+v"(vlo[q][0]), "+v"(vlo[q][1]), "+v"(vlo[q][2]), "+v"(vlo[q][3]), "+v"(vhi[q][0]), "+v"(vhi[q][1]), "+v"(vhi[q][2]), "+v"(vhi[q][3]));
                    if (q < 3) { if (q == 0) ATT_VR(1); if (q == 1) ATT_VR(2); if (q == 2) ATT_VR(3); }
                    u32x4 pw; pw.x = cvt_pk_bf16(st[kt][8 * s + 0], st[kt][8 * s + 1]); pw.y = cvt_pk_bf16(st[kt][8 * s + 2], st[kt][8 * s + 3]); pw.z = cvt_pk_bf16(st[kt][8 * s + 4], st[kt][8 * s + 5]); pw.w = cvt_pk_bf16(st[kt][8 * s + 6], st[kt][8 * s + 7]);
                    asm volatile("s_nop 1");
                    const bf16x8 pf = __builtin_bit_cast(bf16x8, pw);
#pragma unroll
                    for (int dt = 0; dt < 4; ++dt) { const bf16x8 a2 = __builtin_shufflevector(vlo[q][dt], vhi[q][dt], 0, 1, 2, 3, 4, 5, 6, 7);
                        ot[dt] = __builtin_amdgcn_mfma_f32_32x32x16_bf16(a2, pf, ot[dt], 0, 0, 0); } }
#undef ATT_VR
            }
          }
        }
        const float inv = 1.0f / l_run;
#pragma unroll
        for (int dt = 0; dt < 4; ++dt)
#pragma unroll
            for (int g4 = 0; g4 < 4; ++g4) { u32x2 w; w.x = cvt_pk_bf16(ot[dt][4 * g4] * inv, ot[dt][4 * g4 + 1] * inv); w.y = cvt_pk_bf16(ot[dt][4 * g4 + 2] * inv, ot[dt][4 * g4 + 3] * inv);
                *(LAS u32x2*)(Ow + r * KPB + (32 * dt + 8 * g4 + 4 * h) * 2) = w; }
        asm volatile("s_waitcnt lgkmcnt(0)" ::: "memory");
#pragma unroll
        for (int it = 0; it < 8; ++it) { const int row = it * 4 + (lane >> 4), c16 = lane & 15;
            const u32x4 v = *(const LAS u32x4*)(Ow + row * KPB + c16 * 16);
            *(u32x4*)(AO + (size_t)(b * SEQ + q0 + row) * DM + hq * 128 + c16 * 8) = v; }
        asm volatile("s_waitcnt lgkmcnt(0)" ::: "memory");
    }
#undef ATT_QLOAD
#undef ATT_LOAD_T
    __syncthreads();
}

__global__ void __launch_bounds__(512, 2) fwd(Args a) {
    extern __shared__ __attribute__((aligned(16))) unsigned char lds_raw[];
    LAS unsigned char* lds = (LAS unsigned char*)lds_raw;
    cg::grid_group grid = cg::this_grid();
    const int tid = threadIdx.x, lane = tid & 63, wid = __builtin_amdgcn_readfirstlane(tid >> 6);
    const int G = gridDim.x, bx = blockIdx.x;
    const int gw = bx * NWAVES + wid, NGW = G * NWAVES;
    unsigned char* ws = a.ws;
    volatile LAS unsigned long long* pstamp = (volatile LAS unsigned long long*)(lds + 147392);
    if (PROBE >= 0 && bx == 0 && tid == 0) pstamp[1] = 0ull;
    volatile LAS unsigned* bst = (volatile LAS unsigned*)(lds + 147424);
    if (tid < 2) bst[tid] = 0u;
    __syncthreads();
    const XcdBarrier gbar = xcd_barrier_post((unsigned*)(ws + WS_BAR), bst);
#define GRID_BAR() xcd_barrier(gbar)
    float* mod = (float*)(ws + WS_MOD);
    bf16_t* WinT = (bf16_t*)(ws + WS_WIN); bf16_t* WuT = (bf16_t*)(ws + WS_WU); bf16_t* WaT = (bf16_t*)(ws + WS_WA); bf16_t* WfT = (bf16_t*)(ws + WS_WF);
    bf16_t* WoT = (bf16_t*)(ws + WS_WO); bf16_t* WupT = (bf16_t*)(ws + WS_WUP); bf16_t* WdT = (bf16_t*)(ws + WS_WD); bf16_t* Ft = (bf16_t*)(ws + WS_FT);
    bf16_t* Hb = (bf16_t*)(ws + WS_H); bf16_t* QKV = (bf16_t*)(ws + WS_QKV); bf16_t* UT = (bf16_t*)(ws + WS_UT); bf16_t* AO = (bf16_t*)(ws + WS_AO); bf16_t* RE = (bf16_t*)(ws + WS_RE);
    bf16_t* TMP = (bf16_t*)(ws + WS_TMP); bf16_t* MERGED = (bf16_t*)(ws + WS_MERGED); bf16_t* ACT = (bf16_t*)(ws + WS_ACT);
    unsigned char* H8 = ws + WS_H8; unsigned char* Wg8 = ws + WS_WG8;
    bf16_t* HF = (bf16_t*)(ws + WS_HF); bf16_t* Vf = (bf16_t*)(ws + WS_V); float* U1024 = (float*)(ws + WS_U1024);
    bf16_t* X1B = (bf16_t*)(ws + WS_X1B);
    bf16_t* Gt = (bf16_t*)a.out;

    PH_BEGIN(0);
    {
        LAS f32x2* tab = (LAS f32x2*)(lds + 131072);
        if (tid < 256) { float s, c; sincospif((float)tid * (1.0f / 128.0f), &s, &c); tab[tid] = (f32x2){c * 0.0625f, s * 0.0625f}; }
        __syncthreads();
        for (int jb = bx; jb < NMOD / 64; jb += G) {
            const int col = jb * 64 + lane;
            LAS float* sl = (LAS float*)(lds + wid * 16384);
            float acc[NBATCH];
#pragma unroll
            for (int b = 0; b < NBATCH; ++b) acc[b] = 0.f;
            for (int half = 0; half < 2; ++half) {
                const int k0 = wid * 256 + half * 128;
                for (int i = 0; i < 40; ++i) { const int e = lane + 64 * i, kk = e & 127, bb = e >> 7;
                    const float c = (bb < 4) ? a.cp[bb * DM + k0 + kk] : a.cs[(bb - 4) * DM + k0 + kk];
                    sl[kk * NBATCH + bb] = c / (1.0f + expf(-c)); }
                asm volatile("s_waitcnt lgkmcnt(0)" ::: "memory");
#pragma unroll 8
                for (int kk = 0; kk < 128; ++kk) { const float w = a.w_mod[(size_t)(k0 + kk) * NMOD + col];
#pragma unroll
                    for (int q = 0; q < 5; ++q) { const f32x4 s = *(const LAS f32x4*)(sl + kk * NBATCH + 4 * q);
                        acc[4 * q] += s.x * w; acc[4 * q + 1] += s.y * w; acc[4 * q + 2] += s.z * w; acc[4 * q + 3] += s.w * w; } }
                asm volatile("s_waitcnt lgkmcnt(0)" ::: "memory");
            }
            LAS float* red = (LAS float*)(lds + wid * 16384 + 10240);
#pragma unroll
            for (int b = 0; b < NBATCH; ++b) red[b * 64 + lane] = acc[b];
            __syncthreads();
            for (int e = tid; e < NBATCH * 64; e += 512) { const int b = e >> 6, l = e & 63; float s = a.b_mod[jb * 64 + l];
#pragma unroll
                for (int w = 0; w < 8; ++w) s += ((const LAS float*)(lds + w * 16384 + 10240))[b * 64 + l];
                mod[(size_t)b * NMOD + jb * 64 + l] = s; }
            __syncthreads();
        }
        if (wid < 4) {
            for (int f = bx * 4 + wid; f < 1024; f += G * 4) {
                const int g = f >> 8, k0 = (f & 255) * 8;
                LAS float* wl = (LAS float*)(lds + wid * 16384);
#pragma unroll
                for (int i = 0; i < 8; ++i) { const f32x4 v = *(const f32x4*)(a.w_in + (size_t)(k0 + i) * 4096 + 3072 + g * 256 + 4 * lane);
                    wl[(4 * lane + 0) * 8 + i] = v.x; wl[(4 * lane + 1) * 8 + i] = v.y; wl[(4 * lane + 2) * 8 + i] = v.z; wl[(4 * lane + 3) * 8 + i] = v.w; }
                asm volatile("s_waitcnt lgkmcnt(0)" ::: "memory");
                float ac[4][8], as[4][8];
#pragma unroll
                for (int q = 0; q < 4; ++q)
#pragma unroll
                    for (int i = 0; i < 8; ++i) { ac[q][i] = 0.f; as[q][i] = 0.f; }
                int idx0 = 0, idx1 = 0, idx2 = 0, idx3 = 0;
                for (int d = 0; d < 256; ++d) {
                    const f32x4 w0 = *(const LAS f32x4*)(wl + d * 8), w1 = *(const LAS f32x4*)(wl + d * 8 + 4);
                    const float wv[8] = {w0.x, w0.y, w0.z, w0.w, w1.x, w1.y, w1.z, w1.w};
                    const f32x2 t0 = tab[idx0], t1 = tab[idx1], t2 = tab[idx2], t3 = tab[idx3];
                    idx0 = (idx0 + lane) & 255; idx1 = (idx1 + lane + 64) & 255; idx2 = (idx2 + lane + 128) & 255; idx3 = (idx3 + lane + 192) & 255;
#pragma unroll
                    for (int i = 0; i < 8; ++i) { ac[0][i] += wv[i] * t0.x; as[0][i] += wv[i] * t0.y; ac[1][i] += wv[i] * t1.x; as[1][i] += wv[i] * t1.y;
                        ac[2][i] += wv[i] * t2.x; as[2][i] += wv[i] * t2.y; ac[3][i] += wv[i] * t3.x; as[3][i] += wv[i] * t3.y; }
                }
#pragma unroll
                for (int q = 0; q < 4; ++q) { const int cp_ = lane + 64 * q;
                    u32x4 oc, os; oc.x = cvt_pk_bf16(ac[q][0], ac[q][1]); oc.y = cvt_pk_bf16(ac[q][2], ac[q][3]); oc.z = cvt_pk_bf16(ac[q][4], ac[q][5]); oc.w = cvt_pk_bf16(ac[q][6], ac[q][7]);
                    os.x = cvt_pk_bf16(as[q][0], as[q][1]); os.y = cvt_pk_bf16(as[q][2], as[q][3]); os.z = cvt_pk_bf16(as[q][4], as[q][5]); os.w = cvt_pk_bf16(as[q][6], as[q][7]);
                    *(u32x4*)(WuT + (size_t)(g * 256 + cp_) * DM + k0) = oc; *(u32x4*)(WuT + (size_t)(1024 + g * 256 + cp_) * DM + k0) = os; }
                asm volatile("s_waitcnt lgkmcnt(0)" ::: "memory");
            }
        }
        {
            constexpr int I1 = 32 * 96, I2 = 32 * 128, I3 = 32 * 64, I4 = 16 * 64, I5 = 32 * 64, I6 = 32 * 352, I7 = 88 * 64, I8 = 512;
            constexpr int NITEMS = I1 + I2 + I3 + I4 + I5 + I6 + I7 + I8;
            const int shard = bx & 7; unsigned* ctr = (unsigned*)(ws + WS_CTL) + 64 * shard;
            LAS float* scr = (LAS float*)(lds + wid * 16384);
            for (;;) {
                int it = 0; if (lane == 0) it = (int)atomicAdd(ctr, 1u);
                it = __builtin_amdgcn_readfirstlane(it) * 8 + shard;
                if (it >= NITEMS) break;
                int rr = it;
                if (rr < I1) { transpose_item(a.w_in, 4096, DM, WinT, 3072, 0, SrcIdent{}, scr, rr, lane); continue; } rr -= I1;
                if (rr < I2) { transpose_item_fp8(a.w_gate, 4096, DM, Wg8, 4096, 64.0f, scr, rr, lane); continue; } rr -= I2;
                if (rr < I3) { transpose_item(a.w_attn, DM, DM, WaT, DM, 0, SrcIdent{}, scr, rr, lane); continue; } rr -= I3;
                if (rr < I4) { transpose_item(a.w_four, DM, 1024, WfT, DM, 0, SrcIdent{}, scr, rr, lane); continue; } rr -= I4;
                if (rr < I5) { transpose_item(a.w_out, DM, DM, WoT, DM, 0, SrcIdent{}, scr, rr, lane); continue; } rr -= I5;
                if (rr < I6) { transpose_item(a.w_up, 2 * DFF, DM, WupT, 2 * DFF, 0, SrcUp{}, scr, rr, lane); continue; } rr -= I6;
                if (rr < I7) { transpose_item(a.w_down, DM, DFF, WdT, DM, 0, SrcIdent{}, scr, rr, lane); continue; } rr -= I7;
#pragma unroll 1
                for (int i = 0; i < 8; ++i) { const int piece = rr * 512 + lane + 64 * i, e0 = piece * 8, row = e0 >> 10, k = e0 & 1023, part = row >> 10, t = row & 1023;
                    float v[8];
#pragma unroll
                    for (int jj = 0; jj < 8; ++jj) { const int s_ = k + jj, idx = (t * s_) & 2047; float sn, cs; sincospif((float)idx * (1.0f / 1024.0f), &sn, &cs); v[jj] = (part ? -sn : cs) * 0.022097086912079608f; }
                    u32x4 o; o.x = cvt_pk_bf16(v[0], v[1]); o.y = cvt_pk_bf16(v[2], v[3]); o.z = cvt_pk_bf16(v[4], v[5]); o.w = cvt_pk_bf16(v[6], v[7]);
                    *(u32x4*)(Ft + (size_t)e0) = o; }
            }
        }
    }
    if (gridDim.y == 0x7fffu) grid.sync();
    GRID_BAR();
    PH_END(0);

    PH_BEGIN(1);
    norm_pair_rows(a.xp, a.xs, a.g_mix, mod + 0 * DM, mod + 1 * DM, Hb, HF, H8, gw, NGW, lane);
    GRID_BAR();
    PH_END(1);

    PH_BEGIN(2);
    { pg8::Order S; S.init(MTOK / 256, 12, G, bx, 0); pg8::EpiQKVG E{QKV, Gt, a.b_gate, 1.0f};
      pg8::gemm_phase<pg8::EpiQKVG, true, true>(lds, Hb, WinT, DM, S, E); }
    { pg8::Order S; S.init(MTOK / 256, 16, G, bx, 5); pg8::EpiQKVG E{QKV, Gt, a.b_gate, 0.00390625f};
      pg8::gemm_phase<pg8::EpiQKVG, false, true, true>(lds, (const bf16_t*)H8, (const bf16_t*)(Wg8 - (size_t)12 * 256 * DM), DM / 2, S, E); }
    PH_END(2); PH_BEGIN(3);
    { int lane = threadIdx.x & 63; asm volatile("" : "+v"(lane));
    for (int d = gw; d < NBATCH * 1024; d += NGW) { const int b = d >> 10, c = d & 1023;
        const u32x4* wr_ = (const u32x4*)(WuT + (size_t)c * DM); const u32x4* hr_ = (const u32x4*)(Hb + ((size_t)b * SEQ + 1024) * DM); float s = 0.f;
#pragma unroll
        for (int i = 0; i < 4; ++i) { const u32x4 w = wr_[lane + 64 * i], hv = hr_[lane + 64 * i];
            s += bf_lo(w.x) * bf_lo(hv.x) + bf_hi(w.x) * bf_hi(hv.x) + bf_lo(w.y) * bf_lo(hv.y) + bf_hi(w.y) * bf_hi(hv.y) + bf_lo(w.z) * bf_lo(hv.z) + bf_hi(w.z) * bf_hi(hv.z) + bf_lo(w.w) * bf_lo(hv.w) + bf_hi(w.w) * bf_hi(hv.w); }
        s = wave_sum(s); if (lane == 0) U1024[d] = s * 0.022097086912079608f; } }
    { pg8::Order S; S.init(NBATCH * 32, 1, G, (bx + G / 2) % G, 2); pg8::EpiBf16 E{Vf, 1024, 2};
      pg8::gemm_phase<pg8::EpiBf16, true, true>(lds, WuT, HF, DM, S, E); }
    GRID_BAR();
    PH_END(3);

    PH_BEGIN(4);
    {
        int ub = bx, ue = NBATCH * 4 * 32, us = G;
        if (G == 256) { if (bx < 64) { ub = bx * 7; ue = ub + 7; } else { ub = 448 + (bx - 64) * 11; ue = ub + 11; } us = 1; }
        attn_phase(lds, QKV, AO, a.sink, ub, ue, us);
    }
    PH_END(4); PH_BEGIN(5);
    { int lane = threadIdx.x & 63; asm volatile("" : "+v"(lane));
    for (int d = gw; d < NBATCH * 1024; d += NGW) { const u32x4* vr = (const u32x4*)(Vf + (size_t)d * 1024); float s = 0.f;
#pragma unroll
        for (int i = 0; i < 2; ++i) { const u32x4 w = vr[lane + 64 * i]; s += (bf_lo(w.x) - bf_hi(w.x)) + (bf_lo(w.y) - bf_hi(w.y)) + (bf_lo(w.z) - bf_hi(w.z)) + (bf_lo(w.w) - bf_hi(w.w)); }
        s = wave_sum(s); if (lane == 0) { const float v = s * 0.022097086912079608f + U1024[d]; RE[((size_t)(d >> 10) * SEQ + 1024) * 1024 + (d & 1023)] = (bf16_t)(cvt_pk_bf16(v, 0.f) & 0xffffu); } } }
    { pg8::Order S; S.init(NBATCH * 16, 1, G, bx, 4); pg8::EpiREsym E{RE, TMP, U1024};
      pg8::gemm_phase<pg8::EpiREsym, true, true>(lds, Ft, Vf, 1024, S, E); }
    GRID_BAR();
    PH_END(5);

    PH_BEGIN(6);
    { pg8::Order S; S.init(MTOK / 256, 8, G, bx, 0); pg8::EpiMerge<0> E{Gt, nullptr, TMP};
      pg8::gemm_phase<pg8::EpiMerge<0>, true, true>(lds, AO, WaT, DM, S, E); }
    { pg8::Order S; S.init(MTOK / 256, 8, G, bx, 0); pg8::EpiMerge<1> E{Gt, TMP, MERGED};
      pg8::gemm_phase<pg8::EpiMerge<1>, true, true>(lds, RE, WfT, 1024, S, E); }
    GRID_BAR();
    PH_END(6);

    PH_BEGIN(7);
    { pg8::Order S; S.init(MTOK / 256, 8, G, bx, 0); pg8::EpiResT<1> E{a.xp, a.xs, NPR / 256, nullptr, mod + 2 * DM, nullptr, X1B};
      pg8::gemm_phase<pg8::EpiResT<1>, true, true>(lds, MERGED, WoT, DM, S, E); }
    GRID_BAR();
    PH_END(7);

    PH_BEGIN(8);
    norm_rows_bf16src(X1B, a.g_ffn, mod + 3 * DM, mod + 4 * DM, Hb, gw, NGW, lane);
    GRID_BAR();
    PH_END(8);

    PH_BEGIN(9);
    { pg8::Order S; S.init(MTOK / 256, 44, G, bx, 0); pg8::EpiSwiGLU E{ACT};
      pg8::gemm_phase<pg8::EpiSwiGLU, true, true>(lds, Hb, WupT, DM, S, E); }
    GRID_BAR();
    PH_END(9);

    PH_BEGIN(10);
    { pg8::Order S; S.init(MTOK / 256, 8, G, bx, 0); pg8::EpiResT<2> E{nullptr, nullptr, 0, X1B, mod + 5 * DM, a.out, nullptr};
      pg8::gemm_phase<pg8::EpiResT<2>, true, true>(lds, ACT, WdT, DFF, S, E); }
    GRID_BAR();
    PH_END(10);

    PH_BEGIN(11);
    norm_rows<false, false>(a.out, a.out + (size_t)NPR * DM, a.g_final, nullptr, nullptr, a.out, gw, NGW, lane);
    PH_END(11);
    PH_BEGIN(12);
    if (PROBE >= 0 && ((PROBE >> 12) & 1)) { for (int i = 0; i < 5; ++i) GRID_BAR(); }
    PH_END(12);
    if (PROBE >= 0 && bx == 0 && tid == 0) { const unsigned long long d = pstamp[1], t2 = __builtin_amdgcn_s_memrealtime(); while (__builtin_amdgcn_s_memrealtime() - t2 < d) __builtin_amdgcn_s_sleep(8); }
}

extern "C" void kernel_launch(void* const* d_in, const int* in_sizes, int n_in, void* d_out, int out_size, void* d_ws, size_t ws_size, hipStream_t stream) {
    static int grid = 0;
    if (grid == 0) {
        if (n_in != 18 || out_size != MTOK * DM || ws_size < WS_END) { fprintf(stderr, "kernel_launch: unexpected problem (n_in %d, out %d, ws %zu < %zu)\n", n_in, out_size, ws_size, (size_t)WS_END); grid = -1; return; }
        int dev = 0, cus = 0, per_cu = 0;
        (void)hipGetDevice(&dev); (void)hipDeviceGetAttribute(&cus, hipDeviceAttributeMultiprocessorCount, dev);
        if (hipFuncSetAttribute((const void*)fwd, hipFuncAttributeMaxDynamicSharedMemorySize, LDS_BYTES) != hipSuccess) { fprintf(stderr, "kernel_launch: hipFuncSetAttribute failed\n"); grid = -1; return; }
        if (hipOccupancyMaxActiveBlocksPerMultiprocessor(&per_cu, (const void*)fwd, NWAVES * 64, LDS_BYTES) != hipSuccess || per_cu < 1) { fprintf(stderr, "kernel_launch: occupancy query says %d blocks/CU\n", per_cu); per_cu = 1; }
        (void)hipGetLastError();
        grid = cus * per_cu;
    }
    if (grid < 0) return;
    (void)hipMemsetAsync((char*)d_ws + WS_CTL, 0, CTL_BYTES, stream);
    Args a{};
    a.xp = (const float*)d_in[0]; a.xs = (const float*)d_in[1]; a.cp = (const float*)d_in[2]; a.cs = (const float*)d_in[3]; a.w_mod = (const float*)d_in[4]; a.b_mod = (const float*)d_in[5];
    a.g_mix = (const float*)d_in[6]; a.w_in = (const float*)d_in[7]; a.sink = (const float*)d_in[8]; a.w_attn = (const float*)d_in[9]; a.w_four = (const float*)d_in[10]; a.w_gate = (const float*)d_in[11];
    a.b_gate = (const float*)d_in[12]; a.w_out = (const float*)d_in[13]; a.g_ffn = (const float*)d_in[14]; a.w_up = (const float*)d_in[15]; a.w_down = (const float*)d_in[16]; a.g_final = (const float*)d_in[17];
    a.out = (float*)d_out; a.ws = (unsigned char*)d_ws;
    void* args[] = {&a};
    const hipError_t e = hipLaunchCooperativeKernel((void*)fwd, dim3(grid), dim3(NWAVES * 64), args, LDS_BYTES, stream);
    if (e != hipSuccess) fprintf(stderr, "kernel_launch: cooperative launch failed: %s (grid %d)\n", hipGetErrorString(e), grid);
}
```
